# Optimizing an MI355X kernel written in HIP

```python
import jax, jax.numpy as jnp
from jax import lax
import numpy as np

D_MODEL = 4096
BATCH = 1
SEQ = 16384
DEPTH = 1
DEC_BATCH = 8
DEC_SEQ = 16
PAST_LEN = 2048

CHUNK = 64
D_HG = D_MODEL // 2
HG_HEAD_DIM = 128
HG_HEADS = D_HG // HG_HEAD_DIM
D_RW = D_MODEL // 2
RW_HEAD_DIM = 64
RW_HEADS = D_RW // RW_HEAD_DIM
RW_DECAY_LORA = 128
RW_ICLR_LORA = 128
RW_GATE_LORA = 480
D_RW_IN = 3 * D_RW + RW_DECAY_LORA + RW_ICLR_LORA + RW_GATE_LORA
D_IN = 4 * D_HG + D_RW_IN + 2 * D_MODEL
D_FF = 11008
ALPHA = (2 * DEPTH) ** 0.25
BETA = (8 * DEPTH) ** -0.25
LN_EPS = 1e-5
RMS_EPS = 1e-6
RW_GN_EPS = 64e-5

kernel_name = "hgrn2_rwkv7_macaron_deepnorm_stream_step"


def _layer_norm(x, g, b):
    xf = x.astype(jnp.float32)
    mu = jnp.mean(xf, -1, keepdims=True)
    var = jnp.mean(jnp.square(xf - mu), -1, keepdims=True)
    return ((xf - mu) * lax.rsqrt(var + LN_EPS) * g + b).astype(x.dtype)


def _swiglu_ffn(x, w_in, w_down):
    gate, up = jnp.split(x @ w_in, 2, axis=-1)
    return (jax.nn.silu(gate) * up) @ w_down


def _hgrn2_chunked(q, k, v, logf, S0):
    B, T, H, DK = q.shape
    DV = v.shape[-1]
    C = CHUNK if T % CHUNK == 0 else T
    n = T // C
    to_blocks = lambda a: a.reshape(B, n, C, H, a.shape[-1]).transpose(1, 0, 3, 2, 4)
    causal = jnp.tril(jnp.ones((C, C), bool))[None, None, :, :, None]

    def step(S, inp):
        qi, ki, vi, gi = inp
        L = jnp.cumsum(gi, axis=2)
        diff = L[:, :, :, None, :] - L[:, :, None, :, :]
        decay = jnp.exp(jnp.where(causal, diff, -jnp.inf))
        scores = jnp.einsum('bhtd,bhsd,bhtsd->bhts', qi, ki, decay)
        o = jnp.einsum('bhts,bhsv->bhtv', scores, vi) + jnp.einsum('bhtd,bhdv->bhtv', qi * jnp.exp(L), S)
        L_end = L[:, :, -1:, :]
        S_new = jnp.exp(L_end[:, :, 0, :])[..., None] * S + jnp.einsum('bhsd,bhsv->bhdv', ki * jnp.exp(L_end - L), vi)
        return S_new, o

    S, o = lax.scan(step, S0, (to_blocks(q), to_blocks(k), to_blocks(v), to_blocks(logf)))
    return o.transpose(1, 0, 3, 2, 4).reshape(B, T, H, DV), S


def _rwkv7_scan(r, w, k, v, a, b, S0):
    def step(S, inp):
        rt, wt, kt, vt, at, bt = inp
        Sa = jnp.einsum('bhvk,bhk->bhv', S, at)
        S = S * wt[:, :, None, :] + Sa[..., None] * bt[:, :, None, :] + vt[..., None] * kt[:, :, None, :]
        return S, jnp.einsum('bhvk,bhk->bhv', S, rt)
    xs = tuple(t.transpose(1, 0, 2, 3) for t in (r, w, k, v, a, b))
    S, y = lax.scan(step, S0, xs)
    return y.transpose(1, 0, 2, 3), S


def _token_mix(h, hg_S0, rw_S0, shift0, lb, w_in, hg_norm_g, hg_proj, rw_mu, rw_w0, rw_w2, rw_a0, rw_a2,
               rw_g2, rw_k_k, rw_k_a, rw_r_k, rw_ln_g, rw_ln_b, rw_proj, w_out):
    f32 = jnp.float32
    B, T, _ = h.shape
    z = h @ w_in
    cuts = [D_HG, 2 * D_HG, 3 * D_HG, 4 * D_HG, 4 * D_HG + D_RW_IN, 4 * D_HG + D_RW_IN + D_MODEL]
    q, fpre, iv, gh, zr, ga, gb = jnp.split(z, cuts, axis=-1)

    fp = fpre.astype(f32)
    logf = jnp.log(lb + (1.0 - lb) * jax.nn.sigmoid(fp))
    kf = (1.0 - lb) * jax.nn.sigmoid(-fp)
    hs = lambda t: t.reshape(B, T, HG_HEADS, HG_HEAD_DIM)
    o, hg_S = _hgrn2_chunked(hs(q.astype(f32)), hs(kf), hs(iv.astype(f32)), hs(logf), hg_S0.astype(f32))
    o = o * lax.rsqrt(jnp.mean(o * o, -1, keepdims=True) + RMS_EPS)
    o = o.reshape(B, T, D_HG) * hg_norm_g * jax.nn.silu(gh.astype(f32))
    u_a = o.astype(h.dtype) @ hg_proj

    prev = jnp.concatenate([shift0.astype(zr.dtype), zr[:, :-1]], axis=1)
    zs = zr + (prev - zr) * rw_mu
    r, k, v, wd, ad, gd = jnp.split(
        zs, [D_RW, 2 * D_RW, 3 * D_RW, 3 * D_RW + RW_DECAY_LORA, 3 * D_RW + RW_DECAY_LORA + RW_ICLR_LORA], axis=-1)
    w_log = -jax.nn.softplus(-(rw_w0 + jnp.tanh(wd) @ rw_w2).astype(f32)) - 0.5
    decay = jnp.exp(-jnp.exp(w_log))
    a = jax.nn.sigmoid((rw_a0 + ad @ rw_a2).astype(f32))
    g = (jax.nn.sigmoid(gd) @ rw_g2).astype(f32)
    rs = lambda t: t.reshape(B, T, RW_HEADS, RW_HEAD_DIM)
    ph = lambda p: p.astype(f32).reshape(RW_HEADS, RW_HEAD_DIM)
    r_, k_, v_, a_, w_ = rs(r.astype(f32)), rs(k.astype(f32)), rs(v.astype(f32)), rs(a), rs(decay)
    kk = k_ * ph(rw_k_k)
    kk = kk / jnp.maximum(jnp.sqrt(jnp.sum(kk * kk, -1, keepdims=True)), 1e-12)
    k_ = k_ * (1.0 + (a_ - 1.0) * ph(rw_k_a))
    y, rw_S = _rwkv7_scan(r_, w_, k_, v_, -kk, kk * a_, rw_S0.astype(f32))
    mu = jnp.mean(y, -1, keepdims=True)
    var = jnp.mean(jnp.square(y - mu), -1, keepdims=True)
    y = ((y - mu) * lax.rsqrt(var + RW_GN_EPS)).reshape(B, T, D_RW) * rw_ln_g + rw_ln_b
    bonus = jnp.sum(r_ * k_ * ph(rw_r_k), -1, keepdims=True) * v_
    y = (y + bonus.reshape(B, T, D_RW)) * g
    u_b = y.astype(h.dtype) @ rw_proj

    m = jax.nn.sigmoid(ga) * u_a + jax.nn.sigmoid(gb) * u_b
    return m @ w_out, hg_S, rw_S, zr[:, -1:]


def setup_inputs(seed: int = 0) -> dict:
    key = jax.random.key(seed)
    ks = iter(jax.random.split(key, 64))
    nrm = lambda shape, s: jax.random.normal(next(ks), shape, jnp.float32) * s
    uni = lambda shape, lo, hi: jax.random.uniform(next(ks), shape, jnp.float32, lo, hi)
    gain = lambda shape: 1.0 + nrm(shape, 0.02)
    L = DEPTH
    return {
        "x_prompt": nrm((BATCH, SEQ, D_MODEL), 1.0),
        "x_sample": nrm((DEC_BATCH, DEC_SEQ, D_MODEL), 1.0),
        "state_hgrn": nrm((L, DEC_BATCH, HG_HEADS, HG_HEAD_DIM, HG_HEAD_DIM), 0.5),
        "state_rwkv": nrm((L, DEC_BATCH, RW_HEADS, RW_HEAD_DIM, RW_HEAD_DIM), 0.3),
        "state_shift": nrm((L, DEC_BATCH, 1, D_RW_IN), 1.0),
        "ln1_g": gain((L, D_MODEL)),
        "ln1_b": nrm((L, D_MODEL), 0.02),
        "ffn1_w_in": nrm((L, D_MODEL, 2 * D_FF), D_MODEL ** -0.5),
        "ffn1_w_down": nrm((L, D_FF, D_MODEL), BETA * D_FF ** -0.5),
        "ln2_g": gain((L, D_MODEL)),
        "ln2_b": nrm((L, D_MODEL), 0.02),
        "w_in": nrm((L, D_MODEL, D_IN), D_MODEL ** -0.5),
        "hg_lb": nrm((L + 1, D_HG), 0.3),
        "hg_norm_g": gain((L, D_HG)),
        "hg_proj": nrm((L, D_HG, D_MODEL), D_HG ** -0.5),
        "rw_mu": uni((L, D_RW_IN), 0.0, 1.0),
        "rw_w0": uni((L, D_RW), -6.0, -1.0),
        "rw_w2": nrm((L, RW_DECAY_LORA, D_RW), 0.5 * RW_DECAY_LORA ** -0.5),
        "rw_a0": nrm((L, D_RW), 0.1),
        "rw_a2": nrm((L, RW_ICLR_LORA, D_RW), RW_ICLR_LORA ** -0.5),
        "rw_g2": nrm((L, RW_GATE_LORA, D_RW), RW_GATE_LORA ** -0.5),
        "rw_k_k": 0.85 + nrm((L, D_RW), 0.02),
        "rw_k_a": gain((L, D_RW)),
        "rw_r_k": nrm((L, D_RW), 0.1),
        "rw_ln_g": gain((L, D_RW)),
        "rw_ln_b": nrm((L, D_RW), 0.02),
        "rw_proj": nrm((L, D_RW, D_MODEL), D_RW ** -0.5),
        "w_out": nrm((L, D_MODEL, D_MODEL), BETA * D_MODEL ** -0.5),
        "ln3_g": gain((L, D_MODEL)),
        "ln3_b": nrm((L, D_MODEL), 0.02),
        "ffn2_w_in": nrm((L, D_MODEL, 2 * D_FF), D_MODEL ** -0.5),
        "ffn2_w_down": nrm((L, D_FF, D_MODEL), BETA * D_FF ** -0.5),
    }


def reference(x_prompt, x_sample, state_hgrn, state_rwkv, state_shift, ln1_g, ln1_b, ffn1_w_in, ffn1_w_down,
              ln2_g, ln2_b, w_in, hg_lb, hg_norm_g, hg_proj, rw_mu, rw_w0, rw_w2, rw_a0, rw_a2, rw_g2, rw_k_k,
              rw_k_a, rw_r_k, rw_ln_g, rw_ln_b, rw_proj, w_out, ln3_g, ln3_b, ffn2_w_in, ffn2_w_down):
    f32 = jnp.float32
    lb_all = jnp.cumsum(jax.nn.softmax(hg_lb.astype(f32), axis=0), axis=0)

    def trunk(x, hg_S, rw_S, shift):
        new_hg, new_rw, new_sh = [], [], []
        for l in range(DEPTH):
            x = _layer_norm(ALPHA * x + 0.5 * _swiglu_ffn(x, ffn1_w_in[l], ffn1_w_down[l]), ln1_g[l], ln1_b[l])
            m, s_hg, s_rw, s_sh = _token_mix(
                x, hg_S[l], rw_S[l], shift[l], lb_all[l], w_in[l], hg_norm_g[l], hg_proj[l], rw_mu[l], rw_w0[l],
                rw_w2[l], rw_a0[l], rw_a2[l], rw_g2[l], rw_k_k[l], rw_k_a[l], rw_r_k[l], rw_ln_g[l], rw_ln_b[l],
                rw_proj[l], w_out[l])
            x = _layer_norm(ALPHA * x + m, ln2_g[l], ln2_b[l])
            x = _layer_norm(ALPHA * x + 0.5 * _swiglu_ffn(x, ffn2_w_in[l], ffn2_w_down[l]), ln3_g[l], ln3_b[l])
            new_hg.append(s_hg)
            new_rw.append(s_rw)
            new_sh.append(s_sh)
        return x, jnp.stack(new_hg), jnp.stack(new_rw), jnp.stack(new_sh)

    B = x_prompt.shape[0]
    hg0 = jnp.zeros((DEPTH, B, HG_HEADS, HG_HEAD_DIM, HG_HEAD_DIM), f32)
    rw0 = jnp.zeros((DEPTH, B, RW_HEADS, RW_HEAD_DIM, RW_HEAD_DIM), f32)
    sh0 = jnp.zeros((DEPTH, B, 1, D_RW_IN), x_prompt.dtype)
    y_prompt, hgrn_prompt, rwkv_prompt, shift_prompt = trunk(x_prompt, hg0, rw0, sh0)
    y_sample, hgrn_sample, rwkv_sample, shift_sample = trunk(x_sample, state_hgrn, state_rwkv, state_shift)
    return (y_prompt, y_sample, hgrn_prompt, rwkv_prompt, shift_prompt, hgrn_sample, rwkv_sample, shift_sample)
```

```cpp
#include <hip/hip_runtime.h>
#include <stdio.h>

#define LAS __attribute__((address_space(3)))
#define GAS __attribute__((address_space(1)))
typedef unsigned short bf16;
typedef short bf16x8 __attribute__((ext_vector_type(8)));
typedef float f32x4 __attribute__((ext_vector_type(4)));
typedef float f32x2 __attribute__((ext_vector_type(2)));
typedef float f32x16 __attribute__((ext_vector_type(16)));
typedef unsigned u32x4 __attribute__((ext_vector_type(4)));
typedef unsigned u32x2 __attribute__((ext_vector_type(2)));

constexpr int D = 4096, MPR = 16384, MSM = 128, MR = MPR + MSM, MP = 16640;
constexpr int DFF = 11008, NFF = 2 * DFF;
constexpr int DH = 2048;
constexpr int DRIN = 6880, DRINP = 6912;
constexpr int NZ = 8192 + DRINP + 8192;
constexpr int LDZH = 8192, LDZR = DRINP, LDZG = 8192;
constexpr float ALPHA = 1.18920711500272f;
constexpr int HGU = 4096 + 128;
constexpr int RWU = 32 * 256 + 256;
constexpr int NREC = MR * 32;

constexpr size_t O_Y = 0, O_HGP = 67633152, O_RWP = 67895296, O_SHP = 68026368, O_HGS = 68033248, O_RWS = 70130400, O_SHS = 71178976, O_END = 71234016;

constexpr size_t MiB = 1u << 20;
constexpr size_t WS_CTL = 0, CTL_ZERO_BYTES = 64 * 1024;
constexpr size_t WS_XB = 1 * MiB;
constexpr size_t WS_WFI = 131 * MiB;
constexpr size_t WS_WFD = 303 * MiB;
constexpr size_t WS_H = 389 * MiB;
constexpr size_t WS_WIN = 739 * MiB;
constexpr size_t WS_ZH = 921 * MiB, WS_ZR = 1181 * MiB, WS_ZG = 1401 * MiB;
constexpr size_t WS_HGP = 1661 * MiB, WS_RWP = 1677 * MiB, WS_WOUT = 1693 * MiB, WS_LW2 = 1725 * MiB, WS_LA2 = 1726 * MiB, WS_LG2 = 1727 * MiB;
constexpr size_t WS_AL = 1729 * MiB;
constexpr size_t WS_RK = 1762 * MiB;
constexpr size_t WS_WC = 1765 * MiB;
constexpr size_t WS_ADEC = 1768 * MiB;
constexpr size_t WS_SZ = 1771 * MiB, WS_SQ = 1779 * MiB, WS_SST = 1787 * MiB;
constexpr size_t WS_END = 1795 * MiB;
constexpr size_t WS_WIN8 = 859 * MiB;
constexpr size_t WS_XB8 = 1181 * MiB;
constexpr int NSEG = 16, SEGLEN = MPR / NSEG;
constexpr size_t WS_OI = 131 * MiB;
constexpr size_t WS_UT = 261 * MiB;
constexpr size_t WS_Q0 = 525 * MiB;
constexpr size_t WS_ST = 590 * MiB;
constexpr size_t WS_OA = 856 * MiB;
constexpr size_t WS_REC = 131 * MiB;
constexpr size_t WS_VS = 647 * MiB;
constexpr size_t WS_Y = 921 * MiB;
constexpr size_t WS_C = 1050 * MiB;
constexpr size_t WS_G = 776 * MiB;
constexpr size_t WS_LOGW = 921 * MiB, WS_ASIG = 1051 * MiB;
constexpr size_t WS_OB = 389 * MiB;
constexpr size_t WS_MB = 986 * MiB;
constexpr size_t WS_T1 = 921 * MiB, WS_T2 = 389 * MiB, WS_T3 = 921 * MiB;

constexpr int LDS_BYTES = 147456;
constexpr int MISC_OFF = LDS_BYTES - 256;

__device__ __forceinline__ float bf2f(bf16 x) { return __uint_as_float(((unsigned)x) << 16); }
typedef __bf16 bf16x2_t __attribute__((ext_vector_type(2)));
__device__ __forceinline__ unsigned cvt_pk_bf16(float lo, float hi) { return __builtin_bit_cast(unsigned, __builtin_convertvector((f32x2){lo, hi}, bf16x2_t)); }
__device__ __forceinline__ unsigned pk2(float lo, float hi) { return cvt_pk_bf16(lo, hi); }
__device__ __forceinline__ unsigned pk4_f8(float a, float b, float c, float d) { int w = __builtin_amdgcn_cvt_pk_fp8_f32(a, b, 0, false); w = __builtin_amdgcn_cvt_pk_fp8_f32(c, d, w, true); return (unsigned)w; }
__device__ __forceinline__ unsigned f2bf(float f) { return cvt_pk_bf16(f, 0.f) & 0xffffu; }
__device__ __forceinline__ float sigmoidf_(float x) { return __builtin_amdgcn_rcpf(1.0f + __expf(-x)); }

__device__ __forceinline__ unsigned pk4_i8(float a, float b, float c, float d, float s) {
    const unsigned ua = __float_as_uint(__builtin_amdgcn_fmed3f(a * s, -127.f, 127.f) + 12582912.f), ub = __float_as_uint(__builtin_amdgcn_fmed3f(b * s, -127.f, 127.f) + 12582912.f);
    const unsigned uc = __float_as_uint(__builtin_amdgcn_fmed3f(c * s, -127.f, 127.f) + 12582912.f), ud = __float_as_uint(__builtin_amdgcn_fmed3f(d * s, -127.f, 127.f) + 12582912.f);
    return (ua & 0xffu) | ((ub & 0xffu) << 8) | ((uc & 0xffu) << 16) | (ud << 24);
}
constexpr float I8_CLIP = 4.f, I8_ACT = 127.f / I8_CLIP, I8_W = 127.f * 64.f / I8_CLIP, I8_DEQ = 1.f / (I8_ACT * I8_W);
namespace pg8 {
constexpr float W8SCALE_DN = 128.f;
constexpr float W8SCALE = 64.f;
constexpr int BM = 256, BK = 64, HALF = 128, HTB = HALF * BK * 2, STAGE_BYTES = 8 * HTB, NXCD = 8, WGM = 8;
__host__ __device__ __forceinline__ int lds_byte(int r, int c) { const int st = (r >> 4) * 2 + (c >> 5), rr = r & 15, cc = c & 31, ob = rr * 64 + cc * 2; return st * 1024 + (ob ^ (((ob >> 9) & 1) << 5)); }
__host__ __device__ __forceinline__ void stage_rc(int b, int& R, int& C) { const int st = b / 1024, sb = b % 1024, swz = sb ^ (((sb >> 9) & 1) << 5); R = (st >> 1) * 16 + swz / 64; C = (st & 1) * 32 + (swz % 64) / 2; }
__host__ __device__ __forceinline__ int perm32(int rho) { const int n = rho >> 4, i = rho & 15; return 8 * (i >> 2) + 4 * n + (i & 3); }
struct Unit { int pm, pn; };
struct Gemm { const bf16* A; const bf16* Bt; int M, N, K, lda, ldb; };
struct StaticOrder {
    int nM, nN, nwg, G, c, wgm;
    __device__ void init(int M, int N, int G_, int c_, int wgm_ = WGM) { nM = M / BM; nN = N / BM; nwg = nM * nN; G = G_; c = c_; wgm = wgm_; }
    __device__ bool next(int i, Unit& u) const {
        const long L = (long)i * G + c; if (L >= nwg) return false;
        int wgid = (int)L; { const int q = nwg / NXCD, r = nwg % NXCD, xcd = wgid % NXCD, off = wgid / NXCD; wgid = (xcd < r ? xcd * (q + 1) : r * (q + 1) + (xcd - r) * q) + off; }
        const int nig = wgm * nN, gid = wgid / nig, fm = gid * wgm, gsz = (nM - fm) < wgm ? (nM - fm) : wgm;
        u.pm = fm + ((wgid % nig) % gsz); u.pn = (wgid % nig) / gsz; return true;
    }
};
typedef int i32x8 __attribute__((ext_vector_type(8)));
typedef int i32x4 __attribute__((ext_vector_type(4)));
template <class T, class = void> struct IsI8 { static constexpr bool value = false; };
template <class T> struct IsI8<T, decltype((void)T::I8)> { static constexpr bool value = T::I8; };
template <class T, class = void> struct IsF8 { static constexpr bool value = false; };
template <class T> struct IsF8<T, decltype((void)T::F8)> { static constexpr bool value = T::F8; };
template <class T> __device__ __forceinline__ const T* sgpr_ptr(const T* p) { const unsigned long long v = (unsigned long long)p;
    const unsigned lo = __builtin_amdgcn_readfirstlane((unsigned)v), hi = __builtin_amdgcn_readfirstlane((unsigned)(v >> 32)); return (const T*)(((unsigned long long)hi << 32) | lo); }
template <class Epi>
__device__ __forceinline__ void gemm_phase(LAS unsigned char* lds, const Gemm g_in, const StaticOrder& S, const Epi& E) {
    Gemm g = g_in; g.A = sgpr_ptr(g_in.A); g.Bt = sgpr_ptr(g_in.Bt);
    int tid = threadIdx.x; asm volatile("" : "+v"(tid));
    const int wid = __builtin_amdgcn_readfirstlane(tid >> 6), lane = tid & 63, wr = wid >> 2, wc = wid & 3, fr = lane & 15, fq = lane >> 4;
    int nt = g.K / BK; asm volatile("" : "+s"(nt));
    unsigned voffA, voffB;
    { int R, C; stage_rc(tid * 16, R, C); const int Rb = Epi::PERM ? ((R & ~31) + perm32(R & 31)) : R;
      voffA = (unsigned)(R * g.lda + C) * 2u; voffB = (unsigned)(Rb * g.ldb + C) * 2u; }
    const size_t rsA = (size_t)64 * g.lda * 2, rsB = (size_t)64 * g.ldb * 2;
    const size_t kstep = (size_t)(BK * 2);
    const size_t hsA = (size_t)HALF * g.lda * 2, hsB = (size_t)HALF * g.ldb * 2, tsA = 2 * hsA, tsB = 2 * hsB;
    const unsigned ldsw = (unsigned)wid * 1024u;
    const int aoff = lds_byte(wr * 64 + fr, fq * 8), boff = lds_byte(wc * 32 + fr, fq * 8);
#define PG8_SA(b, h) (((b) * 2 + (h)) * HTB)
#define PG8_SB(b, h) ((4 + (b) * 2 + (h)) * HTB)
#define PG8_STAGE(bufoff, gbase, X) do { _Pragma("unroll") for (int _i = 0; _i < 2; ++_i) { \
        const char* gp_ = (const char*)(gbase) + (_i ? rs##X : (size_t)0); const unsigned la_ = (unsigned)(size_t)(lds + (bufoff) + ldsw + _i * 8192); \
        asm volatile("s_mov_b32 m0, %2\n\ts_nop 0\n\tglobal_load_lds_dwordx4 %0, %1" :: "v"(voff##X), "s"(gp_), "s"(la_) : "memory", "m0"); } } while (0)
#define PG8_LDA(dst, b, h) do { _Pragma("unroll") for (int m = 0; m < 4; ++m) _Pragma("unroll") for (int k = 0; k < 2; ++k) dst[m][k] = *(const LAS bf16x8*)(lds + PG8_SA(b, h) + aoff + m * 2048 + k * 1024); } while (0)
#define PG8_LDB(dst, b, h) do { _Pragma("unroll") for (int n = 0; n < 2; ++n) _Pragma("unroll") for (int k = 0; k < 2; ++k) dst[n][k] = *(const LAS bf16x8*)(lds + PG8_SB(b, h) + boff + n * 2048 + k * 1024); } while (0)
#ifdef F8_NMAJOR
#define F8_LOOP _Pragma("unroll") for (int n = 0; n < 2; ++n) _Pragma("unroll") for (int m = 0; m < 4; ++m)
#else
#define F8_LOOP _Pragma("unroll") for (int m = 0; m < 4; ++m) _Pragma("unroll") for (int n = 0; n < 2; ++n)
#endif
#define PG8_MMA(ai, bj, At, Bt) do { __builtin_amdgcn_s_setprio(1); \
        if constexpr (IsF8<Epi>::value) { i32x8 a8[4], b8[2]; \
            _Pragma("unroll") for (int m = 0; m < 4; ++m) a8[m] = __builtin_shufflevector(__builtin_bit_cast(i32x4, At[m][0]), __builtin_bit_cast(i32x4, At[m][1]), 0, 1, 2, 3, 4, 5, 6, 7); \
            _Pragma("unroll") for (int n = 0; n < 2; ++n) b8[n] = __builtin_shufflevector(__builtin_bit_cast(i32x4, Bt[n][0]), __builtin_bit_cast(i32x4, Bt[n][1]), 0, 1, 2, 3, 4, 5, 6, 7); \
            F8_LOOP asm volatile("v_mfma_f32_16x16x128_f8f6f4 %0, %1, %2, %0" : "+v"(acc[ai][bj][m][n]) : "v"(b8[n]), "v"(a8[m])); } \
        else if constexpr (IsI8<Epi>::value) { _Pragma("unroll") for (int m = 0; m < 4; ++m) _Pragma("unroll") for (int n = 0; n < 2; ++n) _Pragma("unroll") for (int k = 0; k < 2; ++k) \
            acc[ai][bj][m][n] = __builtin_bit_cast(f32x4, __builtin_amdgcn_mfma_i32_16x16x64_i8(__builtin_bit_cast(i32x4, Bt[n][k]), __builtin_bit_cast(i32x4, At[m][k]), __builtin_bit_cast(i32x4, acc[ai][bj][m][n]), 0, 0, 0)); } \
        else { _Pragma("unroll") for (int m = 0; m < 4; ++m) _Pragma("unroll") for (int n = 0; n < 2; ++n) _Pragma("unroll") for (int k = 0; k < 2; ++k) \
            acc[ai][bj][m][n] = __builtin_amdgcn_mfma_f32_16x16x32_bf16(Bt[n][k], At[m][k], acc[ai][bj][m][n], 0, 0, 0); } \
        __builtin_amdgcn_s_setprio(0); } while (0)
#define PG8_WAIT_V(n) asm volatile("s_waitcnt vmcnt(" #n ")" ::: "memory")
#define PG8_WAIT_L(n) asm volatile("s_waitcnt lgkmcnt(" #n ")" ::: "memory")
#define PG8_BAR __builtin_amdgcn_s_barrier()
#define PG8_SCHED __builtin_amdgcn_sched_barrier(0)
    Unit cur, nxt; int ui = 0;
    if (!S.next(0, cur)) return;
    f32x4 acc[2][2][4][2];
#pragma unroll
    for (int a = 0; a < 2; ++a)
#pragma unroll
        for (int b = 0; b < 2; ++b)
#pragma unroll
            for (int m = 0; m < 4; ++m)
#pragma unroll
                for (int n = 0; n < 2; ++n) acc[a][b][m][n] = (f32x4){0.f, 0.f, 0.f, 0.f};
    bf16x8 At[4][2], B0[2][2], B1[2][2];
    const char* cA = (const char*)g.A + (size_t)cur.pm * tsA; const char* cB = (const char*)g.Bt + (size_t)cur.pn * tsB;
    PG8_STAGE(PG8_SB(0, 0), cB, B); PG8_STAGE(PG8_SB(0, 1), cB + hsB, B); PG8_STAGE(PG8_SA(0, 0), cA, A); PG8_STAGE(PG8_SA(0, 1), cA + hsA, A);
    if (wr == 1) PG8_BAR;
    PG8_WAIT_V(2); PG8_BAR;
    PG8_STAGE(PG8_SB(1, 0), cB + kstep, B); PG8_STAGE(PG8_SA(1, 0), cA + kstep, A); PG8_STAGE(PG8_SB(1, 1), cB + hsB + kstep, B);
    PG8_WAIT_V(6); PG8_BAR;
    for (;;) {
        const bool has_next = S.next(ui + 1, nxt);
        const char* nA = has_next ? (const char*)g.A + (size_t)nxt.pm * tsA : cA; const char* nB = has_next ? (const char*)g.Bt + (size_t)nxt.pn * tsB : cB;
        for (int t = 0; t < nt; t += 2) {
            const bool last = (t == nt - 2);
            const char* a1 = cA + (size_t)(t + 1) * kstep;
            const char* a2 = last ? nA : cA + (size_t)(t + 2) * kstep; const char* b2 = last ? nB : cB + (size_t)(t + 2) * kstep;
            const char* a3 = a2 + kstep; const char* b3 = b2 + kstep;
            PG8_LDB(B0, 0, 0); PG8_LDB(B1, 0, 1); PG8_SCHED; PG8_LDA(At, 0, 0); PG8_STAGE(PG8_SA(1, 1), a1 + hsA, A);
            PG8_WAIT_V(8); PG8_WAIT_L(0); PG8_BAR; PG8_MMA(0, 0, At, B0); PG8_MMA(0, 1, At, B1); PG8_BAR; PG8_SCHED;
            PG8_LDA(At, 0, 1); PG8_STAGE(PG8_SB(0, 0), b2, B); PG8_STAGE(PG8_SB(0, 1), b2 + hsB, B); PG8_STAGE(PG8_SA(0, 0), a2, A);
            PG8_WAIT_V(8); PG8_WAIT_L(0); PG8_BAR; PG8_MMA(1, 0, At, B0); PG8_MMA(1, 1, At, B1); PG8_BAR; PG8_SCHED;
            PG8_LDB(B0, 1, 0); PG8_LDB(B1, 1, 1); PG8_SCHED; PG8_LDA(At, 1, 0); PG8_STAGE(PG8_SA(0, 1), a2 + hsA, A);
            PG8_WAIT_V(8); PG8_WAIT_L(0); PG8_BAR; PG8_MMA(0, 0, At, B0); PG8_MMA(0, 1, At, B1); PG8_BAR; PG8_SCHED;
            PG8_LDA(At, 1, 1); PG8_STAGE(PG8_SB(1, 0), b3, B); PG8_STAGE(PG8_SB(1, 1), b3 + hsB, B); PG8_STAGE(PG8_SA(1, 0), a3, A);
            PG8_WAIT_V(8); PG8_WAIT_L(0); PG8_BAR; PG8_MMA(1, 0, At, B0); PG8_MMA(1, 1, At, B1); PG8_BAR; PG8_SCHED;
        }
        if (wr == 0) PG8_BAR;
        if constexpr (IsF8<Epi>::value) asm volatile("s_nop 15\n\ts_nop 15" ::: "memory");
        E(acc, cur, wr, wc, fr, fq);
        if (!has_next) break;
#pragma unroll
        for (int a = 0; a < 2; ++a)
#pragma unroll
            for (int b = 0; b < 2; ++b)
#pragma unroll
                for (int m = 0; m < 4; ++m)
#pragma unroll
                    for (int n = 0; n < 2; ++n) acc[a][b][m][n] = (f32x4){0.f, 0.f, 0.f, 0.f};
        cur = nxt; cA = nA; cB = nB; ++ui;
        if (wr == 1) PG8_BAR;
    }
    PG8_WAIT_V(0);
    PG8_BAR;
#undef PG8_SA
#undef PG8_SB
#undef PG8_STAGE
#undef PG8_LDA
#undef PG8_LDB
#undef PG8_MMA
#undef PG8_WAIT_V
#undef PG8_WAIT_L
#undef PG8_BAR
#undef PG8_SCHED
}

template <int IN, bool OUT8> struct EpiSwiGLU {
    static constexpr bool PERM = true, F8 = (IN == 1), I8 = (IN == 2);
    bf16* H;
    __device__ __forceinline__ void operator()(const f32x4 (&acc)[2][2][4][2], const Unit& u, int wr, int wc, int fr, int fq) const {
        asm volatile("" : "+v"(fr), "+v"(fq));
        const int row0 = u.pm * BM + wr * 64 + fr, col0 = u.pn * 128 + wc * 32 + 8 * fq;
#pragma unroll
        for (int ai = 0; ai < 2; ++ai)
#pragma unroll
            for (int m = 0; m < 4; ++m) { bf16* rowp = H + (size_t)(row0 + ai * HALF + m * 16) * DFF + col0;
                float h[8];
#pragma unroll
                for (int n = 0; n < 2; ++n)
#pragma unroll
                    for (int j = 0; j < 4; ++j) { const float ga = acc[ai][0][m][n][j], ua = acc[ai][1][m][n][j];
                        const float gt = IN == 2 ? (float)__float_as_int(ga) * I8_DEQ : (IN == 1 ? ga * (1.f / W8SCALE) : ga), up = IN == 2 ? (float)__float_as_int(ua) * I8_DEQ : (IN == 1 ? ua * (1.f / W8SCALE) : ua); h[n * 4 + j] = gt * sigmoidf_(gt) * up; }
                if (OUT8) *(u32x2*)((unsigned char*)H + (size_t)(row0 + ai * HALF + m * 16) * DFF + col0) = (u32x2){pk4_f8(h[0], h[1], h[2], h[3]), pk4_f8(h[4], h[5], h[6], h[7])};
                else { u32x4 w; w.x = cvt_pk_bf16(h[0], h[1]); w.y = cvt_pk_bf16(h[2], h[3]); w.z = cvt_pk_bf16(h[4], h[5]); w.w = cvt_pk_bf16(h[6], h[7]);
                    *(u32x4*)rowp = w; } }
    }
};
template <bool SPLIT, bool F8_ = false> struct EpiResid {
    static constexpr bool PERM = true, F8 = F8_;
    bf16* out; const float* xp; const float* xs; const bf16* xb; float scale;
    __device__ __forceinline__ void operator()(const f32x4 (&acc)[2][2][4][2], const Unit& u, int wr, int wc, int fr, int fq) const {
        const int row0 = u.pm * BM + wr * 64 + fr, col0 = u.pn * BM + wc * 32 + 8 * fq;
#pragma unroll
        for (int ai = 0; ai < 2; ++ai) {
            if (u.pm * BM + ai * HALF < MR) {
                f32x4 bv[4][2][2];
#pragma unroll
                for (int m = 0; m < 4; ++m) { const int row = row0 + ai * HALF + m * 16;
                    if (SPLIT) { const float* bp = row < MPR ? xp + (size_t)row * D + col0 : xs + (size_t)(row - MPR) * D + col0;
#pragma unroll
                        for (int bj = 0; bj < 2; ++bj)
#pragma unroll
                            for (int n = 0; n < 2; ++n) bv[m][bj][n] = *(const f32x4*)(bp + bj * HALF + n * 4);
                    } else { const bf16* bp = xb + (size_t)row * D + col0;
#pragma unroll
                        for (int bj = 0; bj < 2; ++bj) { const u32x4 w = *(const u32x4*)(bp + bj * HALF);
                            bv[m][bj][0] = (f32x4){__uint_as_float(w.x << 16), __uint_as_float(w.x & 0xffff0000u), __uint_as_float(w.y << 16), __uint_as_float(w.y & 0xffff0000u)};
                            bv[m][bj][1] = (f32x4){__uint_as_float(w.z << 16), __uint_as_float(w.z & 0xffff0000u), __uint_as_float(w.w << 16), __uint_as_float(w.w & 0xffff0000u)}; } } }
#pragma unroll
                for (int m = 0; m < 4; ++m) { bf16* op = out + (size_t)(row0 + ai * HALF + m * 16) * D + col0;
#pragma unroll
                    for (int bj = 0; bj < 2; ++bj) { const f32x4 v0 = bv[m][bj][0] * ALPHA + acc[ai][bj][m][0] * scale, v1 = bv[m][bj][1] * ALPHA + acc[ai][bj][m][1] * scale;
                        u32x4 w; w.x = cvt_pk_bf16(v0[0], v0[1]); w.y = cvt_pk_bf16(v0[2], v0[3]); w.z = cvt_pk_bf16(v1[0], v1[1]); w.w = cvt_pk_bf16(v1[2], v1[3]);
                        *(u32x4*)(op + bj * HALF) = w; } }
            } }
    }
};
struct EpiZ {
    static constexpr bool PERM = true;
    bf16 *zh, *zr, *zg;
    __device__ __forceinline__ void operator()(const f32x4 (&acc)[2][2][4][2], const Unit& u, int wr, int wc, int fr, int fq) const {
        bf16* base; int ld, colt;
        if (u.pn < 32) { base = zh; ld = LDZH; colt = u.pn * BM; } else if (u.pn < 59) { base = zr; ld = LDZR; colt = (u.pn - 32) * BM; } else { base = zg; ld = LDZG; colt = (u.pn - 59) * BM; }
        const int row0 = u.pm * BM + wr * 64 + fr, col0 = colt + wc * 32 + 8 * fq;
#pragma unroll
        for (int ai = 0; ai < 2; ++ai)
#pragma unroll
            for (int m = 0; m < 4; ++m) { bf16* rowp = base + (size_t)(row0 + ai * HALF + m * 16) * ld + col0;
#pragma unroll
                for (int bj = 0; bj < 2; ++bj) { const f32x4 v0 = acc[ai][bj][m][0], v1 = acc[ai][bj][m][1];
                    u32x4 w; w.x = cvt_pk_bf16(v0[0], v0[1]); w.y = cvt_pk_bf16(v0[2], v0[3]); w.z = cvt_pk_bf16(v1[0], v1[1]); w.w = cvt_pk_bf16(v1[2], v1[3]);
                    *(u32x4*)(rowp + bj * HALF) = w; } }
    }
};
template <bool I8_> struct EpiZr {
    static constexpr bool PERM = true, I8 = I8_;
    bf16 *zh, *zr, *zg;
    __device__ __forceinline__ void operator()(const f32x4 (&acc)[2][2][4][2], const Unit& u, int wr, int wc, int fr, int fq) const {
        asm volatile("" : "+v"(fr), "+v"(fq));
        bf16* base; int ld, colt; const int pn = u.pn;
        if (!I8_) { if (pn < 16) { base = zh; ld = LDZH; colt = (pn + 8) * BM; } else { base = zr; ld = LDZR; colt = (pn - 8) * BM; } }
        else { if (pn < 32) { base = zg; ld = LDZG; colt = pn * BM; } else if (pn < 40) { base = zh; ld = LDZH; colt = (pn - 32) * BM; } else if (pn < 48) { base = zh; ld = LDZH; colt = (pn - 16) * BM; } else { base = zr; ld = LDZR; colt = (pn - 48) * BM; } }
        const int row0 = u.pm * BM + wr * 64 + fr, col0 = colt + wc * 32 + 8 * fq;
#pragma unroll
        for (int ai = 0; ai < 2; ++ai)
#pragma unroll
            for (int m = 0; m < 4; ++m) { bf16* rowp = base + (size_t)(row0 + ai * HALF + m * 16) * ld + col0;
#pragma unroll
                for (int bj = 0; bj < 2; ++bj) { f32x4 v0 = acc[ai][bj][m][0], v1 = acc[ai][bj][m][1];
                    if (I8_) { v0 = __builtin_convertvector(__builtin_bit_cast(i32x4, v0), f32x4) * I8_DEQ; v1 = __builtin_convertvector(__builtin_bit_cast(i32x4, v1), f32x4) * I8_DEQ; }
                    u32x4 w; w.x = cvt_pk_bf16(v0[0], v0[1]); w.y = cvt_pk_bf16(v0[2], v0[3]); w.z = cvt_pk_bf16(v1[0], v1[1]); w.w = cvt_pk_bf16(v1[2], v1[3]);
                    *(u32x4*)(rowp + bj * HALF) = w; } }
    }
};
struct EpiZG8 {
    static constexpr bool PERM = true, I8 = true;
    bf16* zg;
    __device__ __forceinline__ void operator()(const f32x4 (&acc)[2][2][4][2], const Unit& u, int wr, int wc, int fr, int fq) const {
        asm volatile("" : "+v"(fr), "+v"(fq));
        const int row0 = u.pm * BM + wr * 64 + fr, col0 = u.pn * BM + wc * 32 + 8 * fq;
#pragma unroll
        for (int ai = 0; ai < 2; ++ai)
#pragma unroll
            for (int m = 0; m < 4; ++m) { bf16* rowp = zg + (size_t)(row0 + ai * HALF + m * 16) * LDZG + col0;
#pragma unroll
                for (int bj = 0; bj < 2; ++bj) { const f32x4 v0 = __builtin_convertvector(__builtin_bit_cast(i32x4, acc[ai][bj][m][0]), f32x4) * I8_DEQ, v1 = __builtin_convertvector(__builtin_bit_cast(i32x4, acc[ai][bj][m][1]), f32x4) * I8_DEQ;
                    u32x4 w; w.x = cvt_pk_bf16(v0[0], v0[1]); w.y = cvt_pk_bf16(v0[2], v0[3]); w.z = cvt_pk_bf16(v1[0], v1[1]); w.w = cvt_pk_bf16(v1[2], v1[3]);
                    *(u32x4*)(rowp + bj * HALF) = w; } }
    }
};
struct EpiLoraF32 {
    static constexpr bool PERM = true;
    bf16* out; const float* bias;
    __device__ __forceinline__ void operator()(const f32x4 (&acc)[2][2][4][2], const Unit& u, int wr, int wc, int fr, int fq) const {
        const int row0 = u.pm * BM + wr * 64 + fr, col0 = u.pn * BM + wc * 32 + 8 * fq;
#pragma unroll
        for (int bj = 0; bj < 2; ++bj) { const f32x4 b0 = *(const f32x4*)(bias + col0 + bj * HALF), b1 = *(const f32x4*)(bias + col0 + bj * HALF + 4);
#pragma unroll
            for (int ai = 0; ai < 2; ++ai)
#pragma unroll
                for (int m = 0; m < 4; ++m) { const f32x4 v0 = acc[ai][bj][m][0] + b0, v1 = acc[ai][bj][m][1] + b1;
                    u32x4 w; w.x = cvt_pk_bf16(v0[0], v0[1]); w.y = cvt_pk_bf16(v0[2], v0[3]); w.z = cvt_pk_bf16(v1[0], v1[1]); w.w = cvt_pk_bf16(v1[2], v1[3]);
                    *(u32x4*)(out + (size_t)(row0 + ai * HALF + m * 16) * DH + col0 + bj * HALF) = w; } }
    }
};
struct EpiBf16Plain {
    static constexpr bool PERM = true;
    bf16* O; int ldc;
    __device__ __forceinline__ void operator()(const f32x4 (&acc)[2][2][4][2], const Unit& u, int wr, int wc, int fr, int fq) const {
        const int row0 = u.pm * BM + wr * 64 + fr, col0 = u.pn * BM + wc * 32 + 8 * fq;
#pragma unroll
        for (int ai = 0; ai < 2; ++ai)
#pragma unroll
            for (int m = 0; m < 4; ++m) { bf16* rowp = O + (size_t)(row0 + ai * HALF + m * 16) * ldc + col0;
#pragma unroll
                for (int bj = 0; bj < 2; ++bj) { const f32x4 v0 = acc[ai][bj][m][0], v1 = acc[ai][bj][m][1];
                    u32x4 w; w.x = cvt_pk_bf16(v0[0], v0[1]); w.y = cvt_pk_bf16(v0[2], v0[3]); w.z = cvt_pk_bf16(v1[0], v1[1]); w.w = cvt_pk_bf16(v1[2], v1[3]);
                    *(u32x4*)(rowp + bj * HALF) = w; } }
    }
};
template <bool FIRST> struct EpiProj {
    static constexpr bool PERM = true;
    bf16* mb; const bf16* zg; int goff;
    __device__ __forceinline__ void operator()(const f32x4 (&acc)[2][2][4][2], const Unit& u, int wr, int wc, int fr, int fq) const {
        const int row0 = u.pm * BM + wr * 64 + fr, col0 = u.pn * BM + wc * 32 + 8 * fq;
#pragma unroll
        for (int ai = 0; ai < 2; ++ai) {
            u32x4 gw[4][2], pw[4][2];
#pragma unroll
            for (int m = 0; m < 4; ++m) { const size_t r = (size_t)(row0 + ai * HALF + m * 16);
#pragma unroll
                for (int bj = 0; bj < 2; ++bj) { gw[m][bj] = *(const u32x4*)(zg + r * LDZG + goff + col0 + bj * HALF);
                    pw[m][bj] = (u32x4){0u, 0u, 0u, 0u}; if (!FIRST) pw[m][bj] = *(const u32x4*)(mb + r * D + col0 + bj * HALF); } }
#pragma unroll
            for (int m = 0; m < 4; ++m) { const size_t r = (size_t)(row0 + ai * HALF + m * 16);
#pragma unroll
                for (int bj = 0; bj < 2; ++bj) {
                    float o[8];
#pragma unroll
                    for (int q = 0; q < 4; ++q) { const unsigned gq = gw[m][bj][q], pq = pw[m][bj][q];
                        const float g0 = __uint_as_float(gq << 16), g1 = __uint_as_float(gq & 0xffff0000u), p0 = __uint_as_float(pq << 16), p1 = __uint_as_float(pq & 0xffff0000u);
                        const f32x4 a = acc[ai][bj][m][q >> 1]; const float a0 = a[(q & 1) * 2], a1 = a[(q & 1) * 2 + 1];
                        o[2 * q] = p0 + sigmoidf_(g0) * a0; o[2 * q + 1] = p1 + sigmoidf_(g1) * a1; }
                    u32x4 w; w.x = cvt_pk_bf16(o[0], o[1]); w.y = cvt_pk_bf16(o[2], o[3]); w.z = cvt_pk_bf16(o[4], o[5]); w.w = cvt_pk_bf16(o[6], o[7]);
                    *(u32x4*)(mb + r * D + col0 + bj * HALF) = w; } }
        }
    }
};
}

template <bool F8 = false, class EpiE>
__device__ __forceinline__ void skinny_phase(LAS unsigned char* lds, const bf16* A, int lda, const bf16* Bt, int ldb, int K, const EpiE& epi) {
    int tid = threadIdx.x; asm volatile("" : "+v"(tid));
    const int w = __builtin_amdgcn_readfirstlane(tid >> 6), lane = tid & 63, fr = lane & 15, fq = lane >> 4;
    const int kw = K / 8;
    for (int pc = blockIdx.x; pc < 256; pc += gridDim.x) {
        const int rg = (pc >> 3) & 3, cg = (pc & 7) * 8 + (pc >> 5);
        const bf16* ap = A + (size_t)(MPR + 32 * rg + fr) * lda + w * kw + 8 * fq;
        const bf16* bp = Bt + (size_t)(64 * cg + fr) * ldb + w * kw + 8 * fq;
        const unsigned char* ap8 = (const unsigned char*)A + (size_t)(MPR + 32 * rg + fr) * lda + w * kw + 8 * fq;
        const unsigned char* bp8 = (const unsigned char*)Bt + (size_t)(64 * cg + fr) * ldb + w * kw + 8 * fq;
        f32x4 acc[2][4];
#pragma unroll
        for (int mt = 0; mt < 2; ++mt)
#pragma unroll
            for (int nt = 0; nt < 4; ++nt) acc[mt][nt] = (f32x4){0.f, 0.f, 0.f, 0.f};
#pragma unroll 4
        for (int k0 = 0; k0 < kw; k0 += 32) {
            if constexpr (F8) { long a8[2], b8[4];
#pragma unroll
                for (int mt = 0; mt < 2; ++mt) a8[mt] = *(const long*)(ap8 + (size_t)(16 * mt) * lda + k0);
#pragma unroll
                for (int nt = 0; nt < 4; ++nt) b8[nt] = *(const long*)(bp8 + (size_t)(16 * nt) * ldb + k0);
#pragma unroll
                for (int mt = 0; mt < 2; ++mt)
#pragma unroll
                    for (int nt = 0; nt < 4; ++nt) acc[mt][nt] = __builtin_amdgcn_mfma_f32_16x16x32_fp8_fp8(b8[nt], a8[mt], acc[mt][nt], 0, 0, 0);
                continue; }
            bf16x8 af[2], bfr[4];
#pragma unroll
            for (int mt = 0; mt < 2; ++mt) af[mt] = *(const bf16x8*)(ap + (size_t)(16 * mt) * lda + k0);
#pragma unroll
            for (int nt = 0; nt < 4; ++nt) bfr[nt] = *(const bf16x8*)(bp + (size_t)(16 * nt) * ldb + k0);
#pragma unroll
            for (int mt = 0; mt < 2; ++mt)
#pragma unroll
                for (int nt = 0; nt < 4; ++nt) acc[mt][nt] = __builtin_amdgcn_mfma_f32_16x16x32_bf16(bfr[nt], af[mt], acc[mt][nt], 0, 0, 0);
        }
        LAS float* red = (LAS float*)(lds + w * 8192);
#pragma unroll
        for (int mt = 0; mt < 2; ++mt)
#pragma unroll
            for (int nt = 0; nt < 4; ++nt) *(LAS f32x4*)(red + (16 * mt + fr) * 64 + 16 * nt + 4 * fq) = acc[mt][nt];
        __syncthreads();
        { const int m = tid >> 4, n4 = (tid & 15) * 4; f32x4 sum = (f32x4){0.f, 0.f, 0.f, 0.f};
#pragma unroll
          for (int ww = 0; ww < 8; ++ww) sum = sum + *(const LAS f32x4*)((const LAS float*)(lds + ww * 8192) + m * 64 + n4);
          epi(MPR + 32 * rg + m, 64 * cg + n4, sum); }
        __syncthreads();
    }
}
struct SkResidSplit { bf16* out; const float* xs; float scale;
    __device__ __forceinline__ void operator()(int row, int col, f32x4 a) const { const f32x4 b = *(const f32x4*)(xs + (size_t)(row - MPR) * D + col); const f32x4 t = b * ALPHA + a * scale;
        *(u32x2*)(out + (size_t)row * D + col) = (u32x2){pk2(t[0], t[1]), pk2(t[2], t[3])}; } };
struct SkResidBf { bf16* out; const bf16* xb; float scale;
    __device__ __forceinline__ void operator()(int row, int col, f32x4 a) const { const u32x2 w = *(const u32x2*)(xb + (size_t)row * D + col);
        const f32x4 b = (f32x4){__uint_as_float(w.x << 16), __uint_as_float(w.x & 0xffff0000u), __uint_as_float(w.y << 16), __uint_as_float(w.y & 0xffff0000u)}; const f32x4 t = b * ALPHA + a * scale;
        *(u32x2*)(out + (size_t)row * D + col) = (u32x2){pk2(t[0], t[1]), pk2(t[2], t[3])}; } };
template <bool FIRST> struct SkProj { bf16* mb; const bf16* zg; int goff;
    __device__ __forceinline__ void operator()(int row, int col, f32x4 a) const {
        const u32x2 gw = *(const u32x2*)(zg + (size_t)row * LDZG + goff + col); u32x2 pw = (u32x2){0u, 0u}; if (!FIRST) pw = *(const u32x2*)(mb + (size_t)row * D + col);
        const float g0 = __uint_as_float(gw.x << 16), g1 = __uint_as_float(gw.x & 0xffff0000u), g2 = __uint_as_float(gw.y << 16), g3 = __uint_as_float(gw.y & 0xffff0000u);
        const float p0 = __uint_as_float(pw.x << 16), p1 = __uint_as_float(pw.x & 0xffff0000u), p2 = __uint_as_float(pw.y << 16), p3 = __uint_as_float(pw.y & 0xffff0000u);
        *(u32x2*)(mb + (size_t)row * D + col) = (u32x2){pk2(p0 + sigmoidf_(g0) * a[0], p1 + sigmoidf_(g1) * a[1]), pk2(p2 + sigmoidf_(g2) * a[2], p3 + sigmoidf_(g3) * a[3])}; } };

#define XB_TMO      128
#define XB_XCNT(j)  (256  + 64 * (j))
#define XB_XSUB(j)  (1280 + 64 * (j))
#define XB_XGEN(j)  (2304 + 64 * (j))
#define XB_TOP      3328
#define XB_TOPGEN   3392
#define XCD_BAR_WORDS 3456
#define XB_SPIN_CAP (1u << 20)
__device__ __forceinline__ unsigned xb_ld(unsigned* p)              { return __hip_atomic_load(p, __ATOMIC_RELAXED, __HIP_MEMORY_SCOPE_AGENT); }
__device__ __forceinline__ unsigned xb_add(unsigned* p, unsigned v) { return __hip_atomic_fetch_add(p, v, __ATOMIC_RELAXED, __HIP_MEMORY_SCOPE_AGENT); }
__device__ __forceinline__ unsigned xb_xcc_id() { return (unsigned)__builtin_amdgcn_s_getreg((3 << 11) | 20) & 0xFu; }
#define XB_SPIN(cond, bar) do { unsigned _sp = 0; while (cond) { __builtin_amdgcn_s_sleep(1); \
    if ((++_sp & 255u) == 0u) { if (xb_ld(&(bar)[XB_TMO])) break; if (_sp > XB_SPIN_CAP) { atomicAdd(&(bar)[XB_TMO], 1u); break; } } } } while (0)
struct XcdBarrier { unsigned* bar; unsigned x; volatile LAS unsigned* st; };
__device__ __forceinline__ XcdBarrier xcd_barrier_post(unsigned* bar, volatile LAS unsigned* st) {
    XcdBarrier b; b.bar = bar; b.x = xb_xcc_id(); b.st = st;
    if (threadIdx.x == 0) (void)xb_add(&bar[XB_XCNT(b.x)], 1u);
    return b;
}
__device__ __forceinline__ void xcd_barrier_complete(unsigned* bar, unsigned x, unsigned& nloc, unsigned& nx) {
    const unsigned G = gridDim.x * gridDim.y * gridDim.z;
    unsigned sum, cnt, mine, sp = 0u;
    for (;;) {
        sum = 0u; cnt = 0u; mine = 0u;
#pragma unroll
        for (unsigned j = 0; j < 16; ++j) { const unsigned c = xb_ld(&bar[XB_XCNT(j)]); sum += c; cnt += (c > 0u) ? 1u : 0u; mine = (j == x) ? c : mine; }
        if (sum == G) break;
        __builtin_amdgcn_s_sleep(1);
        if ((++sp & 255u) == 0u) { if (xb_ld(&bar[XB_TMO])) break; if (sp > XB_SPIN_CAP) { atomicAdd(&bar[XB_TMO], 1u); break; } }
    }
    nloc = mine > 0u ? mine : 1u; nx = cnt > 0u ? cnt : 1u;
}
__device__ __forceinline__ void xcd_barrier(const XcdBarrier& b) {
    asm volatile("s_waitcnt vmcnt(0)" ::: "memory");
    __syncthreads();
    if (threadIdx.x == 0) {
        unsigned* bar = b.bar;
        __builtin_amdgcn_s_waitcnt(0);
        unsigned nloc = b.st[0], nx = b.st[1];
        if (nloc == 0u) { xcd_barrier_complete(bar, b.x, nloc, nx); b.st[0] = nloc; b.st[1] = nx; }
        const unsigned old = xb_add(&bar[XB_XSUB(b.x)], 1u);
        const unsigned gen = old / nloc;
        if (old + 1u == (gen + 1u) * nloc) {
            __builtin_amdgcn_fence(__ATOMIC_RELEASE, "agent");
            asm volatile("s_waitcnt vmcnt(0)" ::: "memory");
            const unsigned og = xb_add(&bar[XB_TOP], 1u);
            const unsigned tg = og / nx;
            if (og + 1u == (tg + 1u) * nx) xb_add(&bar[XB_TOPGEN], 1u);
            else XB_SPIN(xb_ld(&bar[XB_TOPGEN]) == tg, bar);
            __builtin_amdgcn_fence(__ATOMIC_ACQUIRE, "agent");
            xb_add(&bar[XB_XGEN(b.x)], 1u);
            asm volatile("s_waitcnt vmcnt(0)" ::: "memory");
        } else {
            XB_SPIN(xb_ld(&bar[XB_XGEN(b.x)]) == gen, bar);
            __builtin_amdgcn_fence(__ATOMIC_ACQUIRE, "agent");
            asm volatile("s_waitcnt vmcnt(0)" ::: "memory");
        }
    }
    __syncthreads();
}

struct Params {
    const float* in[32];
    float* out; unsigned char* ws;
};
struct Frame {
    LAS unsigned char* lds;
    int tid, lane, wave, G, gw, NGW;
    const float* const* in; float* out; unsigned char* ws;
};
#define LDS_WAIT() asm volatile("s_waitcnt lgkmcnt(0)" ::: "memory")
__device__ __forceinline__ float wave_sum(float v) {
#pragma unroll
    for (int o = 1; o < 64; o <<= 1) v += __shfl_xor(v, o);
    return v;
}
enum { I_XP = 0, I_XS, I_SHG, I_SRW, I_SSH, I_LN1G, I_LN1B, I_F1IN, I_F1DN, I_LN2G, I_LN2B, I_WIN, I_HGLB, I_HGNG, I_HGPROJ, I_MU, I_W0, I_W2, I_A0, I_A2, I_G2,
       I_KK, I_KA, I_RK, I_LNG, I_LNB, I_RWPROJ, I_WOUT, I_LN3G, I_LN3B, I_F2IN, I_F2DN };

template <int MAP>
__device__ __forceinline__ void transpose_item(const float* W, int K, int N, int ldw, bf16* WT, LAS float* scr, int item, int lane) {
    const int nblk = N / 32, kb = item / nblk, nb = item % nblk, k0 = 64 * kb, n0 = 32 * nb;
    int dr0 = n0;
    if (MAP == 1) { if (n0 < DFF) dr0 = (n0 >> 7) * 256 + (n0 & 127); else { const int uo = n0 - DFF; dr0 = (uo >> 7) * 256 + 128 + (uo & 127); } }
#pragma unroll 8
    for (int i = 0; i < 32; ++i) { const int kk = 2 * i + (lane >> 5); scr[kk * 33 + (lane & 31)] = W[(size_t)(k0 + kk) * ldw + n0 + (lane & 31)]; }
    LDS_WAIT(); asm volatile("" ::: "memory");
    const int c = lane & 7;
#pragma unroll
    for (int j = 0; j < 4; ++j) { const int n = (lane >> 3) + 8 * j; const LAS float* s = scr + (8 * c) * 33 + n;
        u32x4 o; o.x = pk2(s[0 * 33], s[1 * 33]); o.y = pk2(s[2 * 33], s[3 * 33]); o.z = pk2(s[4 * 33], s[5 * 33]); o.w = pk2(s[6 * 33], s[7 * 33]);
        *(u32x4*)(WT + (size_t)(dr0 + n) * K + k0 + 8 * c) = o; }
    LDS_WAIT(); asm volatile("" ::: "memory");
}
template <int MAP, bool QI8 = false>
__device__ __forceinline__ void transpose_f8_matrix(Frame& F, const float* W, int K, int N, unsigned char* WT, float scl, int ldw = 0) {
    if (ldw == 0) ldw = N;
    LAS float* scr = (LAS float*)(F.lds + F.wave * 16384); const int lane = F.lane;
    const int nblk = N / 32, nitems = (K / 64) * nblk;
    for (int item = F.gw; item < nitems; item += F.NGW) { const int kb = item / nblk, nb = item % nblk, k0 = 64 * kb, n0 = 32 * nb;
        int dr0 = n0; if (MAP == 1) { if (n0 < DFF) dr0 = (n0 >> 7) * 256 + (n0 & 127); else { const int uo = n0 - DFF; dr0 = (uo >> 7) * 256 + 128 + (uo & 127); } }
#pragma unroll 8
        for (int i = 0; i < 32; ++i) { const int kk = 2 * i + (lane >> 5); scr[kk * 33 + (lane & 31)] = W[(size_t)(k0 + kk) * ldw + n0 + (lane & 31)]; }
        LDS_WAIT(); asm volatile("" ::: "memory");
        const int c = lane & 3;
#pragma unroll
        for (int j = 0; j < 2; ++j) { const int n = (lane >> 2) + 16 * j; const LAS float* sp = scr + (16 * c) * 33 + n;
            u32x4 o;
            if (QI8) { o.x = pk4_i8(sp[0 * 33], sp[1 * 33], sp[2 * 33], sp[3 * 33], scl); o.y = pk4_i8(sp[4 * 33], sp[5 * 33], sp[6 * 33], sp[7 * 33], scl);
                o.z = pk4_i8(sp[8 * 33], sp[9 * 33], sp[10 * 33], sp[11 * 33], scl); o.w = pk4_i8(sp[12 * 33], sp[13 * 33], sp[14 * 33], sp[15 * 33], scl); }
            else {
            o.x = pk4_f8(sp[0 * 33] * scl, sp[1 * 33] * scl, sp[2 * 33] * scl, sp[3 * 33] * scl); o.y = pk4_f8(sp[4 * 33] * scl, sp[5 * 33] * scl, sp[6 * 33] * scl, sp[7 * 33] * scl);
            o.z = pk4_f8(sp[8 * 33] * scl, sp[9 * 33] * scl, sp[10 * 33] * scl, sp[11 * 33] * scl); o.w = pk4_f8(sp[12 * 33] * scl, sp[13 * 33] * scl, sp[14 * 33] * scl, sp[15 * 33] * scl); }
            *(u32x4*)(WT + (size_t)(dr0 + n) * K + k0 + 16 * c) = o; }
        LDS_WAIT(); asm volatile("" ::: "memory"); }
}
template <int MAP>
__device__ __forceinline__ void transpose_matrix(Frame& F, const float* W, int K, int N, bf16* WT, int ldw = 0) {
    LAS float* scr = (LAS float*)(F.lds + F.wave * 16384); if (ldw == 0) ldw = N;
    const int nitems = (K / 64) * (N / 32);
    for (int it = F.gw; it < nitems; it += F.NGW) transpose_item<MAP>(W, K, N, ldw, WT, scr, it, F.lane);
}
__device__ __forceinline__ void lora_weight(Frame& F, const float* W, int KR, int KP, bf16* dst) {
    const int total = 2048 * KP; const int gt = blockIdx.x * 512 + F.tid, NT = F.G * 512;
    for (int e = gt; e < total; e += NT) { const int n = e / KP, k = e % KP; dst[e] = (bf16)(k < KR ? f2bf(W[(size_t)k * 2048 + n]) : 0u); }
}
__device__ __forceinline__ void p0_prologue(Frame& F) {
    { unsigned char* x8 = F.ws + WS_XB8; const float* xp = F.in[I_XP]; const float* xs = F.in[I_XS];
      const size_t total8 = (size_t)MP * D / 8; const size_t gt = (size_t)blockIdx.x * 512 + F.tid, NT = (size_t)F.G * 512;
      for (size_t e = gt; e < total8; e += NT) { const size_t el = e * 8; const int row = (int)(el / D);
          u32x2 o = (u32x2){0u, 0u};
          if (row < MR) { const float* src = row < MPR ? xp + el : xs + (el - (size_t)MPR * D); const f32x4 a = *(const f32x4*)src, b = *(const f32x4*)(src + 4);
              o.x = pk4_i8(a[0], a[1], a[2], a[3], I8_ACT); o.y = pk4_i8(b[0], b[1], b[2], b[3], I8_ACT); }
          *(u32x2*)(x8 + el) = o; } }
    transpose_f8_matrix<1, true>(F, F.in[I_F1IN], D, NFF, F.ws + WS_WFI, I8_W);
    transpose_f8_matrix<0>(F, F.in[I_F1DN], DFF, D, F.ws + WS_WFD, pg8::W8SCALE_DN);
    { const int ldw = 8192 + DRIN + 8192; const float* W = F.in[I_WIN]; bf16* wb = (bf16*)(F.ws + WS_WIN); unsigned char* w8 = F.ws + WS_WIN8;
      transpose_matrix<0>(F, W + 2048, D, 4096, wb, ldw);
      transpose_matrix<0>(F, W + 8192 + 2048, D, DRIN - 2048, wb + (size_t)4096 * D, ldw);
      transpose_f8_matrix<0, true>(F, W + 8192 + DRIN, D, 8192, w8, I8_W, ldw);
      transpose_f8_matrix<0, true>(F, W, D, 2048, w8 + (size_t)8192 * D, I8_W, ldw);
      transpose_f8_matrix<0, true>(F, W + 6144, D, 2048, w8 + (size_t)10240 * D, I8_W, ldw);
      transpose_f8_matrix<0, true>(F, W + 8192, D, 2048, w8 + (size_t)12288 * D, I8_W, ldw); }
    { bf16* wz = (bf16*)(F.ws + WS_WIN) + (size_t)(4096 + DRIN - 2048) * D; const int total8 = 32 * D / 8; const int gt = blockIdx.x * 512 + F.tid;
      for (int e = gt; e < total8; e += F.G * 512) *(u32x4*)(wz + (size_t)e * 8) = (u32x4){0u, 0u, 0u, 0u}; }
    transpose_matrix<0>(F, F.in[I_HGPROJ], DH, D, (bf16*)(F.ws + WS_HGP));
    transpose_matrix<0>(F, F.in[I_RWPROJ], DH, D, (bf16*)(F.ws + WS_RWP));
    transpose_matrix<0>(F, F.in[I_WOUT], D, D, (bf16*)(F.ws + WS_WOUT));
    lora_weight(F, F.in[I_W2], 128, 256, (bf16*)(F.ws + WS_LW2));
    lora_weight(F, F.in[I_A2], 128, 256, (bf16*)(F.ws + WS_LA2));
    lora_weight(F, F.in[I_G2], 480, 512, (bf16*)(F.ws + WS_LG2));
}
template <bool WRITE_BF, bool WRITE_F32, bool WRITE_F8 = false>
__device__ __forceinline__ void ln_phase(Frame& F, const bf16* T, const float* g, const float* b, unsigned char* x8 = nullptr) {
    float* Y = F.out; bf16* xb = (bf16*)(F.ws + WS_XB);
    int lane_ = threadIdx.x & 63; asm volatile("" : "+v"(lane_));
    for (int row = F.gw; row < MR; row += F.NGW) {
        const u32x4* tr = (const u32x4*)(T + (size_t)row * D) + lane_;
        float v[64]; float s = 0.f;
#pragma unroll
        for (int j = 0; j < 8; ++j) { const u32x4 w = tr[64 * j];
#pragma unroll
            for (int q = 0; q < 4; ++q) { v[8 * j + 2 * q] = __uint_as_float(w[q] << 16); v[8 * j + 2 * q + 1] = __uint_as_float(w[q] & 0xffff0000u); s += v[8 * j + 2 * q] + v[8 * j + 2 * q + 1]; } }
        const float mean = wave_sum(s) * (1.f / D); float s2 = 0.f;
#pragma unroll
        for (int i = 0; i < 64; ++i) { v[i] -= mean; s2 += v[i] * v[i]; }
        const float rstd = 1.f / sqrtf(wave_sum(s2) * (1.f / D) + 1e-5f);
#pragma unroll
        for (int j = 0; j < 8; ++j) { const int c0 = 8 * (lane_ + 64 * j);
            const f32x4 g0 = *(const f32x4*)(g + c0), g1 = *(const f32x4*)(g + c0 + 4), b0 = *(const f32x4*)(b + c0), b1 = *(const f32x4*)(b + c0 + 4);
            const f32x4 y0 = (f32x4){v[8 * j], v[8 * j + 1], v[8 * j + 2], v[8 * j + 3]} * rstd * g0 + b0, y1 = (f32x4){v[8 * j + 4], v[8 * j + 5], v[8 * j + 6], v[8 * j + 7]} * rstd * g1 + b1;
            if (WRITE_F32) { *(f32x4*)(Y + (size_t)row * D + c0) = y0; *(f32x4*)(Y + (size_t)row * D + c0 + 4) = y1; }
            if (WRITE_BF) *(u32x4*)(xb + (size_t)row * D + c0) = (u32x4){pk2(y0[0], y0[1]), pk2(y0[2], y0[3]), pk2(y1[0], y1[1]), pk2(y1[2], y1[3])};
            if (WRITE_F8) *(u32x2*)(x8 + (size_t)row * D + c0) = (u32x2){pk4_i8(y0[0], y0[1], y0[2], y0[3], I8_ACT), pk4_i8(y1[0], y1[1], y1[2], y1[3], I8_ACT)}; }
    }
}

#define MFMA32(a, b, c) __builtin_amdgcn_mfma_f32_32x32x16_bf16((a), (b), (c), 0, 0, 0)
__device__ __forceinline__ void hg_decode(int u, int& h, int& row0, int& nvalid) {
    h = u & 15;
    if (u < 4096) { row0 = (u >> 4) * 64; nvalid = 64; } else { row0 = MPR + ((u - 4096) >> 4) * 16; nvalid = 16; }
}
__device__ __forceinline__ void hg_pass1(Frame& F) {
    LAS unsigned char* L = F.lds;
    LAS bf16* QT = (LAS bf16*)(L); LAS bf16* KT = (LAS bf16*)(L + 17408); LAS bf16* KET = (LAS bf16*)(L + 34816); LAS bf16* VT = (LAS bf16*)(L + 53248); LAS bf16* PP = (LAS bf16*)(L + 71680);
    LAS float* SEG = (LAS float*)(L + 80896);
    const bf16* ZH = (const bf16*)(F.ws + WS_ZH);
    bf16* OI = (bf16*)(F.ws + WS_OI); bf16* UT = (bf16*)(F.ws + WS_UT); bf16* Q0 = (bf16*)(F.ws + WS_Q0); float* ADEC = (float*)(F.ws + WS_ADEC);
    const float* hglb = F.in[I_HGLB];
    const int tid = F.tid, d = tid & 127, seg = tid >> 7, w = F.wave, lane = F.lane, r = lane & 31, hh = lane >> 5;
    bf16 rq[16], rf[16], ri[16];
#define HG1_LOAD(uu) do { int h_, r0_, nv_; hg_decode((uu), h_, r0_, nv_); const bf16* zq_ = ZH + (size_t)r0_ * LDZH + h_ * 128 + d; \
        _Pragma("unroll") for (int i = 0; i < 16; ++i) { const int t_ = seg * 16 + i; const int tc_ = t_ < nv_ ? t_ : 0;        \
            rq[i] = zq_[(size_t)tc_ * LDZH]; rf[i] = zq_[(size_t)tc_ * LDZH + 2048]; ri[i] = zq_[(size_t)tc_ * LDZH + 4096]; } } while (0)
    if ((int)blockIdx.x < HGU) HG1_LOAD((int)blockIdx.x);
    for (int u = blockIdx.x; u < HGU; u += F.G) {
        int h, row0, nvalid; hg_decode(u, h, row0, nvalid);
        const int hd = h * 128 + d;
        const float lb = sigmoidf_(hglb[hd] - hglb[2048 + hd]);
        float q[16], kf[16], Lc[16], vv[16]; float run = 0.f;
#pragma unroll
        for (int i = 0; i < 16; ++i) { const int t = seg * 16 + i; const bool valid = t < nvalid;
            const float qv = valid ? bf2f(rq[i]) : 0.f; float fp = valid ? bf2f(rf[i]) : 0.f; const float iv = valid ? bf2f(ri[i]) : 0.f;
            fp = fminf(fmaxf(fp, -30.f), 30.f);
            const float e = __expf(-fp), sg = __builtin_amdgcn_rcpf(1.f + e), sgn = e * sg;
            const float f = lb + (1.f - lb) * sg;
            const float lf = valid ? __logf(f) : 0.f;
            run += lf; Lc[i] = run; q[i] = qv; kf[i] = valid ? (1.f - lb) * sgn : 0.f; vv[i] = iv; }
        { const int un = u + F.G < HGU ? u + F.G : u; HG1_LOAD(un); }
        SEG[seg * 128 + d] = run;
        __syncthreads();
        const float s0 = SEG[d], s1 = SEG[128 + d], s2 = SEG[256 + d], s3 = SEG[384 + d];
        const float base = (seg > 0 ? s0 : 0.f) + (seg > 1 ? s1 : 0.f) + (seg > 2 ? s2 : 0.f);
        const float Lm = s0 + s1, Lend = Lm + s2 + s3;
        const float eLm = __expf(Lm), eEnd = __expf(Lend - Lm);
        unsigned kep[8], vtp[8];
#pragma unroll
        for (int i = 0; i < 16; i += 2) {
            float ke2[2];
#pragma unroll
            for (int ii = 0; ii < 2; ++ii) { const int t = seg * 16 + i + ii; const float Lt = base + Lc[i + ii];
                const float e1 = __expf(Lt - Lm), e2 = __expf(Lm - Lt);
                const float qt = q[i + ii] * e1, kt = kf[i + ii] * e2;
                QT[t * 136 + d] = (bf16)f2bf(qt); KT[t * 136 + d] = (bf16)f2bf(kt);
                if (t < nvalid) Q0[(size_t)(row0 + t) * DH + hd] = (bf16)f2bf(qt * eLm);
                ke2[ii] = kt * eEnd; }
            kep[i >> 1] = pk2(ke2[0], ke2[1]); vtp[i >> 1] = pk2(vv[i], vv[i + 1]); }
        *(LAS u32x4*)(KET + d * 72 + seg * 16) = (u32x4){kep[0], kep[1], kep[2], kep[3]}; *(LAS u32x4*)(KET + d * 72 + seg * 16 + 8) = (u32x4){kep[4], kep[5], kep[6], kep[7]};
        *(LAS u32x4*)(VT + d * 72 + seg * 16) = (u32x4){vtp[0], vtp[1], vtp[2], vtp[3]}; *(LAS u32x4*)(VT + d * 72 + seg * 16 + 8) = (u32x4){vtp[4], vtp[5], vtp[6], vtp[7]};
        if (seg == 0) ADEC[(size_t)u * 128 + d] = __expf(Lend);
        __syncthreads();
        if (w < 4) { const int ts = w >> 1, tt = w & 1;
            f32x16 acc; for (int i = 0; i < 16; ++i) acc[i] = 0.f;
            if (!(ts == 1 && tt == 0)) {
#pragma unroll
                for (int ks = 0; ks < 8; ++ks) { const bf16x8 a = *(const LAS bf16x8*)(KT + (32 * ts + r) * 136 + 16 * ks + 8 * hh), b = *(const LAS bf16x8*)(QT + (32 * tt + r) * 136 + 16 * ks + 8 * hh);
                    acc = MFMA32(a, b, acc); } }
            const int t = 32 * tt + r;
#pragma unroll
            for (int g = 0; g < 4; ++g) { const int sb = 32 * ts + 8 * g + 4 * hh; float p[4];
#pragma unroll
                for (int j = 0; j < 4; ++j) p[j] = (sb + j <= t) ? acc[4 * g + j] : 0.f;
                *(LAS u32x2*)(PP + t * 72 + sb) = (u32x2){pk2(p[0], p[1]), pk2(p[2], p[3])}; } }
        __syncthreads();
        { const int tv = w >> 1, tt = w & 1; f32x16 acc; for (int i = 0; i < 16; ++i) acc[i] = 0.f;
#pragma unroll
          for (int ks = 0; ks < 4; ++ks) { const bf16x8 a = *(const LAS bf16x8*)(VT + (32 * tv + r) * 72 + 16 * ks + 8 * hh), b = *(const LAS bf16x8*)(PP + (32 * tt + r) * 72 + 16 * ks + 8 * hh);
              acc = MFMA32(a, b, acc); }
          const int t = 32 * tt + r;
          if (t < nvalid) { bf16* op = OI + (size_t)(row0 + t) * DH + h * 128 + 32 * tv + 4 * hh;
#pragma unroll
              for (int g = 0; g < 4; ++g) *(u32x2*)(op + 8 * g) = (u32x2){pk2(acc[4 * g], acc[4 * g + 1]), pk2(acc[4 * g + 2], acc[4 * g + 3])}; } }
#pragma unroll
        for (int x = 0; x < 2; ++x) { const int td = w >> 1, tv = 2 * (w & 1) + x; f32x16 acc; for (int i = 0; i < 16; ++i) acc[i] = 0.f;
#pragma unroll
            for (int ks = 0; ks < 4; ++ks) { const bf16x8 a = *(const LAS bf16x8*)(KET + (32 * td + r) * 72 + 16 * ks + 8 * hh), b = *(const LAS bf16x8*)(VT + (32 * tv + r) * 72 + 16 * ks + 8 * hh);
                acc = MFMA32(a, b, acc); }
            bf16* up = UT + ((size_t)u * 128 + 32 * tv + r) * 128 + 32 * td + 4 * hh;
#pragma unroll
            for (int g = 0; g < 4; ++g) *(u32x2*)(up + 8 * g) = (u32x2){pk2(acc[4 * g], acc[4 * g + 1]), pk2(acc[4 * g + 2], acc[4 * g + 3])}; }
        __syncthreads();
    }
#undef HG1_LOAD
}
__device__ __forceinline__ void hg_pass2(Frame& F) {
    const bf16* UT = (const bf16*)(F.ws + WS_UT); const float* ADEC = (const float*)(F.ws + WS_ADEC); bf16* ST = (bf16*)(F.ws + WS_ST);
#define UT2(p) ({ const unsigned w_ = *(const unsigned*)(p); (f32x2){__uint_as_float(w_ << 16), __uint_as_float(w_ & 0xffff0000u)}; })
    const int gt = blockIdx.x * 512 + F.tid, NT = F.G * 512;
    LAS float* AD = (LAS float*)F.lds;
    const size_t cst = (size_t)16 * 128 * 128;
    for (int e0 = blockIdx.x * 512; e0 < 16 * 128 * 64; e0 += NT) { const int e = e0 + F.tid, dp = e & 63, v = (e >> 6) & 127, h = e0 >> 13, d = 2 * dp;
        const bf16* up = UT + ((size_t)h * 128 + v) * 128 + d; bf16* sp = ST + ((size_t)h * 128 + v) * 128 + d;
        unsigned ring[16];
#pragma unroll
        for (int q = 0; q < 16; ++q) ring[q] = *(const unsigned*)(up + (size_t)q * cst);
        for (int i = F.tid; i < 256 * 32; i += 512) { const int c = i >> 5, d4 = (i & 31) * 4; *(LAS f32x4*)(AD + c * 128 + d4) = *(const f32x4*)(ADEC + ((size_t)c * 16 + h) * 128 + d4); }
        __syncthreads();
        f32x2 S = (f32x2){0.f, 0.f};
        for (int c0 = 0; c0 < 240; c0 += 16) {
#pragma unroll
            for (int q = 0; q < 16; ++q) { const int c = c0 + q; const unsigned w_ = ring[q];
                ring[q] = *(const unsigned*)(up + (size_t)(c + 16) * cst);
                const f32x2 a = *(const LAS f32x2*)(AD + c * 128 + d);
                *(unsigned*)(sp + (size_t)c * cst) = pk2(S[0], S[1]);
                S = a * S + (f32x2){__uint_as_float(w_ << 16), __uint_as_float(w_ & 0xffff0000u)}; } }
#pragma unroll
        for (int q = 0; q < 16; ++q) { const int c = 240 + q; const unsigned w_ = ring[q];
            const f32x2 a = *(const LAS f32x2*)(AD + c * 128 + d);
            *(unsigned*)(sp + (size_t)c * cst) = pk2(S[0], S[1]);
            S = a * S + (f32x2){__uint_as_float(w_ << 16), __uint_as_float(w_ & 0xffff0000u)}; }
        float* o = F.out + O_HGP + ((size_t)h * 128 + d) * 128 + v; o[0] = S[0]; o[128] = S[1];
        __syncthreads(); }
    const float* S0 = F.in[I_SHG];
    for (int e = gt; e < 8 * 16 * 128 * 64; e += NT) { const int dp = e & 63, v = (e >> 6) & 127, sh = e >> 13, d = 2 * dp;
        const size_t u = 4096 + sh; const size_t so = ((size_t)sh * 128 + d) * 128 + v;
        const f32x2 S = (f32x2){S0[so], S0[so + 128]};
        const f32x2 a = *(const f32x2*)(ADEC + u * 128 + d), ut = UT2(UT + (u * 128 + v) * 128 + d);
        *(unsigned*)(ST + (u * 128 + v) * 128 + d) = pk2(S[0], S[1]);
        const f32x2 Sn = a * S + ut;
        float* o = F.out + O_HGS + so; o[0] = Sn[0]; o[128] = Sn[1]; }
}
__device__ __forceinline__ void hg_pass3(Frame& F) {
    LAS unsigned char* L = F.lds;
    LAS bf16* STl = (LAS bf16*)L; LAS bf16* Q0l = (LAS bf16*)(L + 34816); LAS float* SS = (LAS float*)(L + 52224);
    const bf16* ST = (const bf16*)(F.ws + WS_ST); const bf16* Q0 = (const bf16*)(F.ws + WS_Q0); const bf16* OI = (const bf16*)(F.ws + WS_OI);
    const bf16* ZH = (const bf16*)(F.ws + WS_ZH); bf16* OA = (bf16*)(F.ws + WS_OA); const float* ng = F.in[I_HGNG];
    const int tid = F.tid, w = F.wave, lane = F.lane, r = lane & 31, hh = lane >> 5;
    for (int u = blockIdx.x; u < HGU; u += F.G) {
        int h, row0, nvalid; hg_decode(u, h, row0, nvalid);
#pragma unroll
        for (int i = 0; i < 4; ++i) { const int c = tid + 512 * i, v = c >> 4, d8 = (c & 15) * 8;
            *(LAS u32x4*)(STl + v * 136 + d8) = *(const u32x4*)(ST + ((size_t)u * 128 + v) * 128 + d8); }
#pragma unroll
        for (int i = 0; i < 2; ++i) { const int c = tid + 512 * i, t = c >> 4, d8 = (c & 15) * 8;
            u32x4 x = (u32x4){0u, 0u, 0u, 0u}; if (t < nvalid) x = *(const u32x4*)(Q0 + (size_t)(row0 + t) * DH + h * 128 + d8);
            *(LAS u32x4*)(Q0l + t * 136 + d8) = x; }
        const int tv = w >> 1, tt = w & 1, t = 32 * tt + r; const bool tvalid = t < nvalid;
        const size_t rowg = (size_t)(row0 + (tvalid ? t : 0));
        const int vb = h * 128 + 32 * tv + 4 * hh;
        f32x4 oi[4]; u32x2 gwv[4];
#pragma unroll
        for (int g = 0; g < 4; ++g) { const u32x2 ow = *(const u32x2*)(OI + rowg * DH + vb + 8 * g); oi[g] = (f32x4){__uint_as_float(ow.x << 16), __uint_as_float(ow.x & 0xffff0000u), __uint_as_float(ow.y << 16), __uint_as_float(ow.y & 0xffff0000u)};
            gwv[g] = *(const u32x2*)(ZH + rowg * LDZH + 6144 + vb + 8 * g); }
        __syncthreads();
        f32x16 acc; for (int i = 0; i < 16; ++i) acc[i] = 0.f;
#pragma unroll
        for (int ks = 0; ks < 8; ++ks) { const bf16x8 a = *(const LAS bf16x8*)(STl + (32 * tv + r) * 136 + 16 * ks + 8 * hh), b = *(const LAS bf16x8*)(Q0l + (32 * tt + r) * 136 + 16 * ks + 8 * hh);
            acc = MFMA32(a, b, acc); }
        float ss = 0.f;
#pragma unroll
        for (int g = 0; g < 4; ++g) {
#pragma unroll
            for (int j = 0; j < 4; ++j) { acc[4 * g + j] += oi[g][j]; ss += acc[4 * g + j] * acc[4 * g + j]; } }
        ss += __shfl_xor(ss, 32);
        if (hh == 0) SS[t * 4 + tv] = ss;
        __syncthreads();
        const float tot = (SS[t * 4] + SS[t * 4 + 1]) + (SS[t * 4 + 2] + SS[t * 4 + 3]);
        const float rs = 1.f / sqrtf(tot * (1.f / 128.f) + 1e-6f);
        if (tvalid) {
#pragma unroll
            for (int g = 0; g < 4; ++g) { const int col = vb + 8 * g;
                const f32x4 gn = *(const f32x4*)(ng + col); const u32x2 gw = gwv[g];
                const float g0 = __uint_as_float(gw.x << 16), g1 = __uint_as_float(gw.x & 0xffff0000u), g2 = __uint_as_float(gw.y << 16), g3 = __uint_as_float(gw.y & 0xffff0000u);
                const float o0 = acc[4 * g] * rs * gn[0] * (g0 * sigmoidf_(g0)), o1 = acc[4 * g + 1] * rs * gn[1] * (g1 * sigmoidf_(g1));
                const float o2 = acc[4 * g + 2] * rs * gn[2] * (g2 * sigmoidf_(g2)), o3 = acc[4 * g + 3] * rs * gn[3] * (g3 * sigmoidf_(g3));
                *(u32x2*)(OA + rowg * DH + col) = (u32x2){pk2(o0, o1), pk2(o2, o3)}; } }
        __syncthreads();
    }
}

__device__ __forceinline__ float dpp_xor1(float x) { return __builtin_bit_cast(float, __builtin_amdgcn_update_dpp(0, __builtin_bit_cast(int, x), 0xB1, 0xF, 0xF, true)); }
__device__ __forceinline__ float dpp_xor2(float x) { return __builtin_bit_cast(float, __builtin_amdgcn_update_dpp(0, __builtin_bit_cast(int, x), 0x4E, 0xF, 0xF, true)); }
__device__ __forceinline__ float dpp_hmir(float x) { return __builtin_bit_cast(float, __builtin_amdgcn_update_dpp(0, __builtin_bit_cast(int, x), 0x141, 0xF, 0xF, true)); }
__device__ __forceinline__ float dpp_mir(float x)  { return __builtin_bit_cast(float, __builtin_amdgcn_update_dpp(0, __builtin_bit_cast(int, x), 0x140, 0xF, 0xF, true)); }
__device__ __forceinline__ float red16(float x) { x += dpp_xor1(x); x += dpp_xor2(x); x += dpp_hmir(x); x += dpp_mir(x); return x; }
__device__ __forceinline__ float wsum(float x) {
    x = red16(x); const int xi = __builtin_bit_cast(int, x);
    const float r0 = __builtin_bit_cast(float, __builtin_amdgcn_readlane(xi, 0)), r1 = __builtin_bit_cast(float, __builtin_amdgcn_readlane(xi, 16));
    const float r2 = __builtin_bit_cast(float, __builtin_amdgcn_readlane(xi, 32)), r3 = __builtin_bit_cast(float, __builtin_amdgcn_readlane(xi, 48));
    return (r0 + r1) + (r2 + r3);
}
__device__ __forceinline__ float zr_prev(const bf16* ZR, const float* sh0, int row, int col) {
    if (row < MPR) return row == 0 ? 0.f : bf2f(ZR[(size_t)(row - 1) * LDZR + col]);
    const int q = row - MPR, s = q >> 4, t = q & 15;
    return t == 0 ? sh0[(size_t)s * DRIN + col] : bf2f(ZR[(size_t)(row - 1) * LDZR + col]);
}
__device__ __forceinline__ void rw_lora_in(Frame& F) {
    const bf16* ZR = (const bf16*)(F.ws + WS_ZR); bf16* AL = (bf16*)(F.ws + WS_AL); const float* mu = F.in[I_MU]; const float* sh0 = F.in[I_SSH];
    for (int row = F.gw; row < MP; row += F.NGW) {
        float o[16];
#pragma unroll
        for (int it = 0; it < 16; ++it) { const int c = F.lane + 64 * it;
            int src = -1, mode = 0;
            if (it < 2) { src = 6144 + c; mode = 0; } else if (it >= 4 && it < 6) { src = 6272 + (c - 256); mode = 1; } else if (it >= 8) { src = 6400 + (c - 512); mode = 2; if (c >= 992) src = -1; }
            o[it] = 0.f;
            if (src >= 0 && row < MR) { const float cur = bf2f(ZR[(size_t)row * LDZR + src]), prev = zr_prev(ZR, sh0, row, src); const float zs = cur + (prev - cur) * mu[src];
                o[it] = mode == 0 ? tanhf(zs) : (mode == 1 ? zs : sigmoidf_(zs)); } }
#pragma unroll
        for (int it = 0; it < 16; ++it) AL[(size_t)row * 1024 + F.lane + 64 * it] = (bf16)f2bf(o[it]);
    }
    for (int q = F.gw; q < 9; q += F.NGW) { const int row = q == 0 ? MPR - 1 : MPR + 16 * (q - 1) + 15; float* o = q == 0 ? F.out + O_SHP : F.out + O_SHS + (size_t)(q - 1) * DRIN;
        for (int c = F.lane; c < DRIN; c += 64) o[c] = bf2f(ZR[(size_t)row * LDZR + c]); }
}
__device__ __forceinline__ void rw_unit_decode(int u, int& h, int& row0, int& n, int& rec0) {
    if (u < 8192) { h = u >> 8; const int c = u & 255; row0 = 64 * c; n = 64; rec0 = h * MPR + row0; }
    else { const int q = u - 8192, s = q >> 5; h = q & 31; row0 = MPR + 16 * s; n = 16; rec0 = 32 * MPR + q * 16; }
}
__device__ __forceinline__ void rw_prep(Frame& F) {
    const bf16* ZR = (const bf16*)(F.ws + WS_ZR); const bf16* LOGW = (const bf16*)(F.ws + WS_LOGW); const bf16* ASIG = (const bf16*)(F.ws + WS_ASIG);
    float* REC = (float*)(F.ws + WS_REC); float* RK = (float*)(F.ws + WS_RK); float* WC = (float*)(F.ws + WS_WC); float* VS = (float*)(F.ws + WS_VS);
    const float* mu = F.in[I_MU]; const float* sh0 = F.in[I_SSH];
    const int lane = F.lane;
    for (int u = F.gw; u < RWU; u += F.NGW) {
        int h, row0, n, rec0; rw_unit_decode(u, h, row0, n, rec0);
        const int col = h * 64 + lane;
        const float mur = mu[col], muk = mu[2048 + col], muv = mu[4096 + col], kkw = F.in[I_KK][col], kaw = F.in[I_KA][col], rkw = F.in[I_RK][col];
        float pr = zr_prev(ZR, sh0, row0, col), pk = zr_prev(ZR, sh0, row0, 2048 + col), pv = zr_prev(ZR, sh0, row0, 4096 + col);
        float Lw = 0.f;
        bf16 cr[8], ck[8], cv[8], lw[8], as[8], nr[8], nk[8], nv[8], nl[8], na[8];
        const bf16* zp = ZR + (size_t)row0 * LDZR + col; const bf16* lp = LOGW + (size_t)row0 * DH + col; const bf16* ap = ASIG + (size_t)row0 * DH + col;
#define PREP_LD(R_, K_, V_, L_, A_, t) do { _Pragma("unroll") for (int q = 0; q < 8; ++q) { const size_t o_ = (size_t)((t) + q); R_[q] = zp[o_ * LDZR]; K_[q] = zp[o_ * LDZR + 2048]; V_[q] = zp[o_ * LDZR + 4096]; L_[q] = lp[o_ * DH]; A_[q] = ap[o_ * DH]; } } while (0)
        PREP_LD(cr, ck, cv, lw, as, 0);
        for (int t0 = 0; t0 < n; t0 += 8) {
            { const int tn = t0 + 8 < n ? t0 + 8 : t0; PREP_LD(nr, nk, nv, nl, na, tn); }
#pragma unroll
            for (int q = 0; q < 8; ++q) { const int row = row0 + t0 + q;
                const float crq = bf2f(cr[q]), ckq = bf2f(ck[q]), cvq = bf2f(cv[q]);
                const float rr = crq + (pr - crq) * mur, kv = ckq + (pk - ckq) * muk;
                const float nx = -bf2f(lw[q]); const float sp = fmaxf(nx, 0.f) + __logf(1.0f + __expf(-fabsf(nx))); const float lgw = -__expf(-sp - 0.5f); const float asg = sigmoidf_(bf2f(as[q]));
                float kk = kv * kkw; const float nrm = sqrtf(wsum(kk * kk)); kk = kk / fmaxf(nrm, 1e-12f);
                const float k_ = kv * (1.f + (asg - 1.f) * kaw);
                const float rk = wsum(rr * k_ * rkw);
                const float eex = __expf(Lw); Lw += lgw; const float ein = __expf(Lw), einv = __expf(-Lw);
                float* rec = REC + (size_t)(rec0 + t0 + q) * 256;
                rec[lane] = -kk * eex; rec[64 + lane] = kk * asg * einv; rec[128 + lane] = k_ * einv; rec[192 + lane] = rr * ein;
                if (lane == 0) RK[(size_t)row * 32 + h] = rk;
                VS[(size_t)row * DH + col] = cvq + (pv - cvq) * muv;
                pr = crq; pk = ckq; pv = cvq; }
#pragma unroll
            for (int q = 0; q < 8; ++q) { cr[q] = nr[q]; ck[q] = nk[q]; cv[q] = nv[q]; lw[q] = nl[q]; as[q] = na[q]; }
        }
#undef PREP_LD
        WC[(size_t)u * 64 + lane] = __expf(Lw);
    }
}
#define SCAN_BAR() do { asm volatile("s_waitcnt lgkmcnt(0)" ::: "memory"); __builtin_amdgcn_s_barrier(); asm volatile("" ::: "memory"); } while (0)
#define SCAN_BAR() do { asm volatile("s_waitcnt lgkmcnt(0)" ::: "memory"); __builtin_amdgcn_s_barrier(); asm volatile("" ::: "memory"); } while (0)
constexpr int TB = 4, NBUF = 4;
struct ScanState { f32x4 A[4], B[4]; };
__device__ __forceinline__ float ksum(float p) { const f32x4 z = (f32x4){0.f, 0.f, 0.f, 0.f}; const f32x4 d = __builtin_amdgcn_mfma_f32_16x16x4f32(1.0f, p, z, 0, 0, 0); return d[0]; }
__device__ __forceinline__ float dot16(const f32x4 (&S)[4], const f32x4 (&a)[4]) {
    f32x2 p0 = (f32x2){S[0][0], S[0][1]} * (f32x2){a[0][0], a[0][1]}, p1 = (f32x2){S[0][2], S[0][3]} * (f32x2){a[0][2], a[0][3]};
#pragma unroll
    for (int q = 1; q < 4; ++q) { p0 = __builtin_elementwise_fma((f32x2){S[q][0], S[q][1]}, (f32x2){a[q][0], a[q][1]}, p0); p1 = __builtin_elementwise_fma((f32x2){S[q][2], S[q][3]}, (f32x2){a[q][2], a[q][3]}, p1); }
    const f32x2 t = p0 + p1; return t[0] + t[1];
}
template <bool useB>
__device__ __forceinline__ void rw_block4(ScanState& st, const LAS unsigned char* pb, const LAS float* pv, float* outA, float* outB, int kg) {
    f32x4 oa[4], ob[4], ok[4], orr[2][4]; float ov;
#define RW_LD4(dst, P) do { _Pragma("unroll") for (int e = 0; e < 4; ++e) dst[e] = *(const LAS f32x4*)((P) + e * 16); } while (0)
    RW_LD4(oa, pb); RW_LD4(ob, pb + 256); RW_LD4(ok, pb + 512); RW_LD4(orr[0], pb + 768); ov = *pv;
    float ykA = 0.f, ykB = 0.f;
    const f32x4 z = (f32x4){0.f, 0.f, 0.f, 0.f};
#pragma unroll
    for (int ss = 0; ss < 4; ++ss) {
        const bool more = ss < 3;
        const LAS unsigned char* pn = pb + (ss + 1) * 1024; const LAS float* vn = pv + (ss + 1) * 16;
        const float pa = dot16(st.A, oa), pq = useB ? dot16(st.B, oa) : 0.f;
        const f32x4 da = __builtin_amdgcn_mfma_f32_16x16x4f32(1.0f, pa, z, 0, 0, 0);
        f32x4 db = z; if (useB) db = __builtin_amdgcn_mfma_f32_16x16x4f32(1.0f, pq, z, 0, 0, 0);
        if (more) RW_LD4(oa, pn);
        if (ss > 0) { const float y = ksum(dot16(st.A, orr[(ss + 1) & 1])); ykA = (kg == ss - 1) ? y : ykA;
            if (useB) { const float c = ksum(dot16(st.B, orr[(ss + 1) & 1])); ykB = (kg == ss - 1) ? c : ykB; } }
        if (more) RW_LD4(orr[(ss + 1) & 1], pn + 768);
        const float sa = da[0], sb = db[0];
        const f32x4 sa4 = (f32x4){sa, sa, sa, sa}, sb4 = (f32x4){sb, sb, sb, sb}, v4 = (f32x4){ov, ov, ov, ov};
#pragma unroll
        for (int e = 0; e < 4; ++e) { st.A[e] = __builtin_elementwise_fma(ob[e], sa4, st.A[e]); st.A[e] = __builtin_elementwise_fma(ok[e], v4, st.A[e]); if (useB) st.B[e] = __builtin_elementwise_fma(ob[e], sb4, st.B[e]); }
        if (more) { RW_LD4(ob, pn + 256); RW_LD4(ok, pn + 512); ov = *vn; }
    }
    { const float y = ksum(dot16(st.A, orr[1])); ykA = (kg == 3) ? y : ykA; outA[(size_t)kg * DH] = ykA;
      if (useB) { const float c = ksum(dot16(st.B, orr[1])); ykB = (kg == 3) ? c : ykB; outB[(size_t)kg * DH] = ykB; } }
#undef RW_LD4
}
__device__ __forceinline__ void rw_issue(Frame& F, int w, int k, int rec, const float* vrow0, const float* wcp, int par, int lane) {
    const float* REC = (const float*)(F.ws + WS_REC);
    LAS unsigned char* dst = F.lds + w * 16384 + k * 4096;
    const unsigned* gp = (const unsigned*)(REC + (size_t)rec * 256 + lane * 4); LAS unsigned* lp = (LAS unsigned*)dst;
    __builtin_amdgcn_global_load_lds(gp, lp, 16, 0, 0); __builtin_amdgcn_global_load_lds(gp, lp, 16, 1024, 0); __builtin_amdgcn_global_load_lds(gp, lp, 16, 2048, 0); __builtin_amdgcn_global_load_lds(gp, lp, 16, 3072, 0);
    __builtin_amdgcn_global_load_lds((const unsigned*)(vrow0 + (size_t)(lane >> 4) * DH + (lane & 15)), (LAS unsigned*)(F.lds + 131072 + w * 1024 + k * 256), 4, 0, 0);
    __builtin_amdgcn_global_load_lds((const unsigned*)(wcp + lane), (LAS unsigned*)(F.lds + 139264 + w * 512 + par * 256), 4, 0, 0);
}
template <bool useB>
__device__ __forceinline__ void rw_job(Frame& F, ScanState& st, int rec0, const float* vrow0, const float* wcp0, int nsteps, float* outA0, float* outB0, int w, int lane) {
    const int r = lane & 15, kg = lane >> 4; const int nb = nsteps / TB;
#define RW_ISS(bb) rw_issue(F, w, (bb) & 3, rec0 + (bb) * TB, vrow0 + (size_t)((bb) * TB) * DH, wcp0 + ((bb) >> 4) * 64, ((bb) >> 4) & 1, lane)
    RW_ISS(0); if (nb > 1) RW_ISS(1); if (nb > 2) RW_ISS(2);
    for (int b = 0; b < nb; ++b) {
        if (b + 3 < nb) { RW_ISS(b + 3); asm volatile("s_waitcnt vmcnt(18)" ::: "memory"); }
        else asm volatile("s_waitcnt vmcnt(0)" ::: "memory");
        const LAS unsigned char* pb = F.lds + w * 16384 + (b & 3) * 4096 + kg * 64; const LAS float* pv = (const LAS float*)(F.lds + 131072 + w * 1024 + (b & 3) * 256) + r;
        rw_block4<useB>(st, pb, pv, outA0 + (size_t)(b * TB) * DH, useB ? outB0 + (size_t)(b * TB) * DH : nullptr, kg);
        if ((b & 15) == 15 || b == nb - 1) {
#pragma unroll
            for (int e = 0; e < 4; ++e) { const f32x4 wc = *(const LAS f32x4*)(F.lds + 139264 + w * 512 + ((b >> 4) & 1) * 256 + kg * 64 + e * 16); st.A[e] = st.A[e] * wc; if (useB) st.B[e] = st.B[e] * wc; } }
        asm volatile("s_waitcnt lgkmcnt(0)" ::: "memory");
    }
#undef RW_ISS
}
__device__ __forceinline__ void rw_scan_prompt(Frame& F, int h, int sl, int half) {
    const float* WC = (const float*)(F.ws + WS_WC); const float* VS = (const float*)(F.ws + WS_VS);
    float* Y = (float*)(F.ws + WS_Y); float* C = (float*)(F.ws + WS_C); float* SZ = (float*)(F.ws + WS_SZ); float* SQ = (float*)(F.ws + WS_SQ);
    const int w = F.wave, lane = F.lane, r = lane & 15, kg = lane >> 4;
    const int seg = 8 * half + w; const bool useB = seg > 0;
    const int row = 16 * sl + r;
    ScanState st;
#pragma unroll
    for (int e = 0; e < 4; ++e) { st.A[e] = (f32x4){0.f, 0.f, 0.f, 0.f};
#pragma unroll
        for (int c = 0; c < 4; ++c) st.B[e][c] = (16 * kg + 4 * e + c == row) ? 1.f : 0.f; }
    const int t0 = seg * SEGLEN;
    if (useB) rw_job<true>(F, st, h * MPR + t0, VS + (size_t)t0 * DH + h * 64 + 16 * sl, WC + (size_t)(h * 256 + (t0 >> 6)) * 64, SEGLEN, Y + (size_t)t0 * DH + h * 64 + row, C + (size_t)(t0 - SEGLEN) * DH + h * 64 + row, w, lane);
    else rw_job<false>(F, st, h * MPR + t0, VS + (size_t)t0 * DH + h * 64 + 16 * sl, WC + (size_t)(h * 256 + (t0 >> 6)) * 64, SEGLEN, Y + (size_t)t0 * DH + h * 64 + row, nullptr, w, lane);
    { float* so = SZ + ((size_t)(h * NSEG + seg) * 64 + row) * 64 + 16 * kg;
#pragma unroll
      for (int e = 0; e < 4; ++e) *(f32x4*)(so + 4 * e) = st.A[e]; }
    if (useB) { float* so = SQ + ((size_t)(h * NSEG + seg) * 64 + row) * 64 + 16 * kg;
#pragma unroll
        for (int e = 0; e < 4; ++e) *(f32x4*)(so + 4 * e) = st.B[e]; }
}
__device__ __forceinline__ void rw_scan_sample(Frame& F) {
    const float* WC = (const float*)(F.ws + WS_WC); const float* VS = (const float*)(F.ws + WS_VS); float* Y = (float*)(F.ws + WS_Y);
    const int w = F.wave, lane = F.lane, r = lane & 15, kg = lane >> 4;
    for (int q = F.gw; q < 1024; q += F.NGW) { const int sl = q & 3, sh = q >> 2, hh = sh & 31, sq = sh >> 5; const int row = 16 * sl + r;
        const float* S0 = F.in[I_SRW] + (size_t)sh * 4096 + (size_t)row * 64 + 16 * kg;
        ScanState st;
#pragma unroll
        for (int e = 0; e < 4; ++e) { st.A[e] = *(const f32x4*)(S0 + 4 * e); st.B[e] = (f32x4){0.f, 0.f, 0.f, 0.f}; }
        rw_job<false>(F, st, 32 * MPR + sh * 16, VS + (size_t)(MPR + 16 * sq) * DH + hh * 64 + 16 * sl, WC + (size_t)(8192 + sh) * 64, 16, Y + (size_t)(MPR + 16 * sq) * DH + hh * 64 + row, nullptr, w, lane);
        float* so = F.out + O_RWS + (size_t)sh * 4096 + (size_t)row * 64 + 16 * kg;
#pragma unroll
        for (int e = 0; e < 4; ++e) *(f32x4*)(so + 4 * e) = st.A[e];
    }
}
__device__ __forceinline__ void rw_scan(Frame& F) {
    for (int bb = blockIdx.x; bb < 256; bb += F.G) { const int x = bb & 7, i = bb >> 3, h = x * 4 + (i >> 3), j = i & 7; rw_scan_prompt(F, h, j >> 1, j & 1); }
    rw_scan_sample(F);
}
__device__ __forceinline__ void rw_compose(Frame& F) {
    const float* SZ = (const float*)(F.ws + WS_SZ); const float* SQ = (const float*)(F.ws + WS_SQ); float* SST = (float*)(F.ws + WS_SST);
    const int lane = F.lane, tid = F.tid;
    LAS float* Qb = (LAS float*)F.lds;
    for (int bb = blockIdx.x; bb < 256; bb += F.G) { const int x = bb & 7, i8 = bb >> 3, h = x * 4 + (i8 >> 3), v = 8 * (i8 & 7) + F.wave;
        const size_t hb = (size_t)(h * NSEG) * 4096;
        f32x4 q0 = *(const f32x4*)(SQ + hb + 4096 + tid * 8), q1 = *(const f32x4*)(SQ + hb + 4096 + tid * 8 + 4);
        float srow = SZ[hb + (size_t)v * 64 + lane];
        float nz = SZ[hb + 4096 + (size_t)v * 64 + lane];
        *(LAS f32x4*)(Qb + tid * 8) = q0; *(LAS f32x4*)(Qb + tid * 8 + 4) = q1;
        __syncthreads();
        for (int k = 1; k < NSEG; ++k) {
            float nzn = 0.f;
            if (k + 1 < NSEG) { const size_t o = hb + (size_t)(k + 1) * 4096; q0 = *(const f32x4*)(SQ + o + tid * 8); q1 = *(const f32x4*)(SQ + o + tid * 8 + 4); nzn = SZ[o + (size_t)v * 64 + lane]; }
            SST[hb + (size_t)k * 4096 + (size_t)v * 64 + lane] = srow;
            const LAS float* q = Qb + ((k - 1) & 1) * 4096 + lane;
            float n0 = nz, n1 = 0.f;
            const int si = __builtin_bit_cast(int, srow);
#pragma unroll
            for (int i = 0; i < 64; i += 2) { n0 = fmaf(__builtin_bit_cast(float, __builtin_amdgcn_readlane(si, i)), q[i * 64], n0); n1 = fmaf(__builtin_bit_cast(float, __builtin_amdgcn_readlane(si, i + 1)), q[(i + 1) * 64], n1); }
            srow = n0 + n1; nz = nzn;
            if (k + 1 < NSEG) { LAS float* qd = Qb + (k & 1) * 4096 + tid * 8; *(LAS f32x4*)qd = q0; *(LAS f32x4*)(qd + 4) = q1; }
            __syncthreads();
        }
        F.out[O_RWP + ((size_t)h * 64 + v) * 64 + lane] = srow;
    }
}
__device__ __forceinline__ void rw_post(Frame& F) {
    const float* Y = (const float*)(F.ws + WS_Y); const float* C = (const float*)(F.ws + WS_C); const float* SST = (const float*)(F.ws + WS_SST); const float* VS = (const float*)(F.ws + WS_VS);
    const float* RK = (const float*)(F.ws + WS_RK); const bf16* G = (const bf16*)(F.ws + WS_G);
    bf16* OB = (bf16*)(F.ws + WS_OB); const float* lng = F.in[I_LNG]; const float* lnb = F.in[I_LNB];
    const int lane = F.lane;
    for (int u = F.gw; u < 32 * (MR / 64); u += F.NGW) { const int h = u & 31, rb0 = (u >> 5) * 64, col = h * 64 + lane;
        const float g_ = lng[col], b_ = lnb[col];
        const int k = rb0 < MPR ? (rb0 / SEGLEN) : 0;
        f32x4 Sr[16];
        if (k > 0) {
#pragma unroll
            for (int q = 0; q < 16; ++q) Sr[q] = *(const f32x4*)(SST + ((size_t)(h * NSEG + k) * 64 + lane) * 64 + 4 * q); }
        const float* yp = Y + (size_t)rb0 * DH + col; const float* vp = VS + (size_t)rb0 * DH + col; const bf16* gp = G + (size_t)rb0 * DH + col; const float* rp = RK + (size_t)rb0 * 32 + h;
        const float* cp = k > 0 ? C + (size_t)(rb0 - SEGLEN) * DH + col : yp;
        float y[8], vv[8], rk[8], cc[8]; bf16 gg[8];
#define POST_LD(Y_, V_, G_, R_, C_, t) do { _Pragma("unroll") for (int q = 0; q < 8; ++q) { const size_t o_ = (size_t)((t) + q) * DH; Y_[q] = yp[o_]; V_[q] = vp[o_]; G_[q] = gp[o_]; R_[q] = rp[((t) + q) * 32]; C_[q] = cp[o_]; } } while (0)
        POST_LD(y, vv, gg, rk, cc, 0);
        for (int t0 = 0; t0 < 64; t0 += 8) {
            float ny[8], nv[8], nr[8], nc[8]; bf16 ng[8];
            const int tn = t0 + 8 < 64 ? t0 + 8 : t0;
            POST_LD(ny, nv, ng, nr, nc, tn);
            if (k > 0) {
                LAS float* cs = (LAS float*)(F.lds + 131072 + F.wave * 1024);
#pragma unroll
                for (int hf = 0; hf < 2; ++hf) {
#pragma unroll
                    for (int q = 0; q < 4; ++q) cs[q * 64 + lane] = cc[4 * hf + q];
                    asm volatile("s_waitcnt lgkmcnt(0)" ::: "memory");
#pragma unroll
                    for (int q = 0; q < 4; ++q) { f32x4 a = (f32x4){0.f, 0.f, 0.f, 0.f};
#pragma unroll
                        for (int i = 0; i < 16; ++i) a = __builtin_elementwise_fma(Sr[i], *(const LAS f32x4*)(cs + q * 64 + 4 * i), a);
                        y[4 * hf + q] += (a[0] + a[1]) + (a[2] + a[3]); }
                    asm volatile("s_waitcnt lgkmcnt(0)" ::: "memory"); }
            }
#pragma unroll
            for (int q = 0; q < 8; ++q) { const int row = rb0 + t0 + q;
                const float mean = wsum(y[q]) * (1.f / 64.f); const float dv = y[q] - mean; const float var = wsum(dv * dv) * (1.f / 64.f);
                const float yn = dv * (1.f / sqrtf(var + 64e-5f)) * g_ + b_;
                OB[(size_t)row * DH + col] = (bf16)f2bf((yn + rk[q] * vv[q]) * bf2f(gg[q])); }
#pragma unroll
            for (int q = 0; q < 8; ++q) { y[q] = ny[q]; vv[q] = nv[q]; gg[q] = ng[q]; rk[q] = nr[q]; cc[q] = nc[q]; }
        }
#undef POST_LD
    }
}

__global__ void __launch_bounds__(512, 2) fwd_kernel(Params P) {
    extern __shared__ __attribute__((aligned(16))) unsigned char lds_raw[];
    Frame F;
    F.lds = (LAS unsigned char*)lds_raw;
    F.tid = threadIdx.x; F.lane = F.tid & 63; F.wave = __builtin_amdgcn_readfirstlane(F.tid >> 6);
    F.G = gridDim.x; F.gw = blockIdx.x * 8 + F.wave; F.NGW = F.G * 8;
    F.in = P.in; F.out = P.out; F.ws = P.ws;
    volatile LAS unsigned* MISC = (volatile LAS unsigned*)(F.lds + MISC_OFF);
    if (F.tid < 32) MISC[F.tid] = 0u;
    __syncthreads();
    XcdBarrier bar = xcd_barrier_post((unsigned*)(P.ws + WS_CTL) + 1024, MISC + 8);
#define GRID_BAR() xcd_barrier(bar)
#ifndef PHASE_MASK
#define PHASE_MASK 0xFFFFFFFFu
#endif
#define PH(k) ((PHASE_MASK >> (k)) & 1u)
    bf16* XB = (bf16*)(P.ws + WS_XB); bf16* HB = (bf16*)(P.ws + WS_H);

    if (PH(0)) p0_prologue(F);
    GRID_BAR();
    if (PH(1)) { pg8::Gemm g{(const bf16*)(P.ws + WS_XB8), (const bf16*)(P.ws + WS_WFI), MP, NFF, D / 2, D / 2, D / 2}; pg8::StaticOrder S; S.init(MP, NFF, F.G, (int)blockIdx.x);
      pg8::EpiSwiGLU<2, true> E{HB}; pg8::gemm_phase(F.lds, g, S, E); }
    GRID_BAR();
    if (PH(2)) { pg8::Gemm g{HB, (const bf16*)(P.ws + WS_WFD), MPR, D, DFF / 2, DFF / 2, DFF / 2}; pg8::StaticOrder S; S.init(MPR, D, F.G, (int)blockIdx.x, 4);
      pg8::EpiResid<true, true> E{(bf16*)(P.ws + WS_T1), P.in[I_XP], P.in[I_XS], nullptr, 0.5f / pg8::W8SCALE_DN}; pg8::gemm_phase(F.lds, g, S, E);
      SkResidSplit K2{(bf16*)(P.ws + WS_T1), P.in[I_XS], 0.5f / pg8::W8SCALE_DN}; skinny_phase<true>(F.lds, HB, DFF, (const bf16*)(P.ws + WS_WFD), DFF, DFF, K2); }
    GRID_BAR();
    if (PH(3)) ln_phase<true, false, true>(F, (const bf16*)(P.ws + WS_T1), P.in[I_LN1G], P.in[I_LN1B], P.ws + WS_H);
    GRID_BAR();
    if (PH(4)) { { pg8::Gemm g{XB, (const bf16*)(P.ws + WS_WIN), MP, 35 * 256, D, D, D}; pg8::StaticOrder S; S.init(MP, 35 * 256, F.G, (int)blockIdx.x);
        pg8::EpiZr<false> E{(bf16*)(P.ws + WS_ZH), (bf16*)(P.ws + WS_ZR), (bf16*)(P.ws + WS_ZG)}; pg8::gemm_phase(F.lds, g, S, E); }
      { pg8::Gemm g{(const bf16*)(P.ws + WS_H), (const bf16*)(P.ws + WS_WIN8), MP, 56 * 256, D / 2, D / 2, D / 2}; pg8::StaticOrder S; S.init(MP, 56 * 256, F.G, (int)((blockIdx.x + 29) % F.G));
        pg8::EpiZr<true> E{(bf16*)(P.ws + WS_ZH), (bf16*)(P.ws + WS_ZR), (bf16*)(P.ws + WS_ZG)}; pg8::gemm_phase(F.lds, g, S, E); } }
    GRID_BAR();
    if (PH(5)) { hg_pass1(F);
    rw_lora_in(F); }
    GRID_BAR();
    if (PH(6)) hg_pass2(F);
    GRID_BAR();
    if (PH(7)) hg_pass3(F);
    GRID_BAR();
    if (PH(8)) { const bf16* AL = (const bf16*)(P.ws + WS_AL);
      { pg8::Gemm g{AL, (const bf16*)(P.ws + WS_LW2), MP, DH, 256, 1024, 256}; pg8::StaticOrder S; S.init(MP, DH, F.G, (int)((blockIdx.x + F.G - 16) % F.G));
        pg8::EpiLoraF32 E{(bf16*)(P.ws + WS_LOGW), P.in[I_W0]}; pg8::gemm_phase(F.lds, g, S, E); }
      { pg8::Gemm g{AL + 256, (const bf16*)(P.ws + WS_LA2), MP, DH, 256, 1024, 256}; pg8::StaticOrder S; S.init(MP, DH, F.G, (int)((blockIdx.x + F.G - 8) % F.G));
        pg8::EpiLoraF32 E{(bf16*)(P.ws + WS_ASIG), P.in[I_A0]}; pg8::gemm_phase(F.lds, g, S, E); }
      { pg8::Gemm g{AL + 512, (const bf16*)(P.ws + WS_LG2), MP, DH, 512, 1024, 512}; pg8::StaticOrder S; S.init(MP, DH, F.G, (int)((blockIdx.x + F.G - 0) % F.G));
        pg8::EpiBf16Plain E{(bf16*)(P.ws + WS_G), DH}; pg8::gemm_phase(F.lds, g, S, E); } }
    GRID_BAR();
    if (PH(9)) rw_prep(F);
    GRID_BAR();
    if (PH(10)) rw_scan(F);
    GRID_BAR();
    rw_compose(F);
    GRID_BAR();
    if (PH(11)) { rw_post(F);
    transpose_f8_matrix<1, true>(F, P.in[I_F2IN], D, NFF, P.ws + WS_WFI, I8_W);
    transpose_f8_matrix<0>(F, P.in[I_F2DN], DFF, D, P.ws + WS_WFD, pg8::W8SCALE_DN); }
    GRID_BAR();
    if (PH(12)) { pg8::Gemm g{(const bf16*)(P.ws + WS_OA), (const bf16*)(P.ws + WS_HGP), MPR, D, DH, DH, DH}; pg8::StaticOrder S; S.init(MPR, D, F.G, (int)blockIdx.x);
      pg8::EpiProj<true> E{(bf16*)(P.ws + WS_MB), (const bf16*)(P.ws + WS_ZG), 0}; pg8::gemm_phase(F.lds, g, S, E);
      SkProj<true> K2{(bf16*)(P.ws + WS_MB), (const bf16*)(P.ws + WS_ZG), 0}; skinny_phase(F.lds, (const bf16*)(P.ws + WS_OA), DH, (const bf16*)(P.ws + WS_HGP), DH, DH, K2); }
    GRID_BAR();
    if (PH(13)) { pg8::Gemm g{(const bf16*)(P.ws + WS_OB), (const bf16*)(P.ws + WS_RWP), MPR, D, DH, DH, DH}; pg8::StaticOrder S; S.init(MPR, D, F.G, (int)blockIdx.x);
      pg8::EpiProj<false> E{(bf16*)(P.ws + WS_MB), (const bf16*)(P.ws + WS_ZG), 4096}; pg8::gemm_phase(F.lds, g, S, E);
      SkProj<false> K2{(bf16*)(P.ws + WS_MB), (const bf16*)(P.ws + WS_ZG), 4096}; skinny_phase(F.lds, (const bf16*)(P.ws + WS_OB), DH, (const bf16*)(P.ws + WS_RWP), DH, DH, K2); }
    GRID_BAR();
    if (PH(14)) { pg8::Gemm g{(const bf16*)(P.ws + WS_MB), (const bf16*)(P.ws + WS_WOUT), MPR, D, D, D, D}; pg8::StaticOrder S; S.init(MPR, D, F.G, (int)blockIdx.x, 4);
      pg8::EpiResid<false> E{(bf16*)(P.ws + WS_T2), nullptr, nullptr, XB, 1.0f}; pg8::gemm_phase(F.lds, g, S, E);
      SkResidBf K2{(bf16*)(P.ws + WS_T2), XB, 1.0f}; skinny_phase(F.lds, (const bf16*)(P.ws + WS_MB), D, (const bf16*)(P.ws + WS_WOUT), D, D, K2); }
    GRID_BAR();
    if (PH(15)) ln_phase<true, false, true>(F, (const bf16*)(P.ws + WS_T2), P.in[I_LN2G], P.in[I_LN2B], P.ws + WS_XB8);
    GRID_BAR();
    if (PH(16)) { pg8::Gemm g{(const bf16*)(P.ws + WS_XB8), (const bf16*)(P.ws + WS_WFI), MP, NFF, D / 2, D / 2, D / 2}; pg8::StaticOrder S; S.init(MP, NFF, F.G, (int)blockIdx.x);
      pg8::EpiSwiGLU<2, true> E{HB}; pg8::gemm_phase(F.lds, g, S, E); }
    GRID_BAR();
    if (PH(17)) { unsigned char* wsp = P.ws; asm volatile("" : "+s"(wsp));
      bf16* xb17 = (bf16*)(wsp + WS_XB); bf16* hb17 = (bf16*)(wsp + WS_H);
      pg8::Gemm g{hb17, (const bf16*)(wsp + WS_WFD), MPR, D, DFF / 2, DFF / 2, DFF / 2}; pg8::StaticOrder S; S.init(MPR, D, F.G, (int)blockIdx.x, 4);
      pg8::EpiResid<false, true> E{(bf16*)(wsp + WS_T3), nullptr, nullptr, xb17, 0.5f / pg8::W8SCALE_DN}; pg8::gemm_phase(F.lds, g, S, E);
      SkResidBf K2{(bf16*)(wsp + WS_T3), xb17, 0.5f / pg8::W8SCALE_DN}; skinny_phase<true>(F.lds, hb17, DFF, (const bf16*)(wsp + WS_WFD), DFF, DFF, K2); }
    GRID_BAR();
    if (PH(18)) ln_phase<false, true>(F, (const bf16*)(P.ws + WS_T3), P.in[I_LN3G], P.in[I_LN3B]);
}

extern "C" void kernel_launch(void* const* d_in, const int* in_sizes, int n_in, void* d_out, int out_size, void* d_ws, size_t ws_size, hipStream_t stream) {
    static int grid = 0;
    if (grid == 0) {
        if (n_in != 32 || out_size != (int)O_END || ws_size < WS_END) { fprintf(stderr, "kernel_launch: unexpected sizes n_in %d out %d ws %zu (need %zu)\n", n_in, out_size, ws_size, (size_t)WS_END); grid = -1; return; }
        int dev = 0, cus = 0;
        if (hipGetDevice(&dev) != hipSuccess || hipDeviceGetAttribute(&cus, hipDeviceAttributeMultiprocessorCount, dev) != hipSuccess) { grid = -1; return; }
        if (hipFuncSetAttribute((const void*)fwd_kernel, hipFuncAttributeMaxDynamicSharedMemorySize, LDS_BYTES) != hipSuccess) { fprintf(stderr, "kernel_launch: hipFuncSetAttribute failed\n"); grid = -1; return; }
        int per_cu = 0; (void)hipOccupancyMaxActiveBlocksPerMultiprocessor(&per_cu, (const void*)fwd_kernel, 512, LDS_BYTES); (void)hipGetLastError();
        if (per_cu < 1) fprintf(stderr, "kernel_launch: occupancy query reports %d\n", per_cu);
        grid = cus;
    }
    if (grid < 0) return;
    (void)hipMemsetAsync((char*)d_ws + WS_CTL, 0, CTL_ZERO_BYTES, stream);
    Params p{};
    for (int i = 0; i < 32; ++i) p.in[i] = (const float*)d_in[i];
    p.out = (float*)d_out; p.ws = (unsigned char*)d_ws;
    hipLaunchKernelGGL(fwd_kernel, dim3(grid), dim3(512), LDS_BYTES, stream, p);
}
```

```cpp
#include <hip/hip_runtime.h>
#include <stdio.h>

#define LAS __attribute__((address_space(3)))
#define GAS __attribute__((address_space(1)))
typedef unsigned short bf16;
typedef short bf16x8 __attribute__((ext_vector_type(8)));
typedef float f32x4 __attribute__((ext_vector_type(4)));
typedef float f32x2 __attribute__((ext_vector_type(2)));
typedef float f32x16 __attribute__((ext_vector_type(16)));
typedef unsigned u32x4 __attribute__((ext_vector_type(4)));
typedef unsigned u32x2 __attribute__((ext_vector_type(2)));

constexpr int D = 4096, MPR = 16384, MSM = 128, MR = MPR + MSM, MP = 16640;
constexpr int DFF = 11008, NFF = 2 * DFF;
constexpr int DH = 2048;
constexpr int DRIN = 6880, DRINP = 6912;
constexpr int NZ = 8192 + DRINP + 8192;
constexpr int LDZH = 8192, LDZR = DRINP, LDZG = 8192;
constexpr float ALPHA = 1.18920711500272f;
constexpr int HGU = 4096 + 128;
constexpr int RWU = 32 * 256 + 256;
constexpr int NREC = MR * 32;

constexpr size_t O_Y = 0, O_HGP = 67633152, O_RWP = 67895296, O_SHP = 68026368, O_HGS = 68033248, O_RWS = 70130400, O_SHS = 71178976, O_END = 71234016;

constexpr size_t MiB = 1u << 20;
constexpr size_t WS_CTL = 0, CTL_ZERO_BYTES = 64 * 1024;
constexpr size_t WS_XB = 1 * MiB;
constexpr size_t WS_WFI = 131 * MiB;
constexpr size_t WS_WFD = 303 * MiB;
constexpr size_t WS_H = 389 * MiB;
constexpr size_t WS_WIN = 739 * MiB;
constexpr size_t WS_ZH = 921 * MiB, WS_ZR = 1181 * MiB, WS_ZG = 1401 * MiB;
constexpr size_t WS_HGP = 1661 * MiB, WS_RWP = 1677 * MiB, WS_WOUT = 1693 * MiB, WS_LW2 = 1725 * MiB, WS_LA2 = 1726 * MiB, WS_LG2 = 1727 * MiB;
constexpr size_t WS_AL = 1729 * MiB;
constexpr size_t WS_RK = 1762 * MiB;
constexpr size_t WS_WC = 1765 * MiB;
constexpr size_t WS_ADEC = 1768 * MiB;
constexpr size_t WS_SZ = 1771 * MiB, WS_SQ = 1779 * MiB, WS_SST = 1787 * MiB;
constexpr size_t WS_END = 1795 * MiB;
constexpr size_t WS_WIN8 = 859 * MiB;
constexpr size_t WS_XB8 = 1181 * MiB;
constexpr int NSEG = 16, SEGLEN = MPR / NSEG;
constexpr size_t WS_OI = 131 * MiB;
constexpr size_t WS_UT = 261 * MiB;
constexpr size_t WS_Q0 = 525 * MiB;
constexpr size_t WS_ST = 590 * MiB;
constexpr size_t WS_OA = 856 * MiB;
constexpr size_t WS_REC = 131 * MiB;
constexpr size_t WS_VS = 647 * MiB;
constexpr size_t WS_Y = 921 * MiB;
constexpr size_t WS_C = 1050 * MiB;
constexpr size_t WS_G = 776 * MiB;
constexpr size_t WS_LOGW = 921 * MiB, WS_ASIG = 1051 * MiB;
constexpr size_t WS_OB = 389 * MiB;
constexpr size_t WS_MB = 986 * MiB;
constexpr size_t WS_T1 = 921 * MiB, WS_T2 = 389 * MiB, WS_T3 = 921 * MiB;

constexpr int LDS_BYTES = 147456;
constexpr int MISC_OFF = LDS_BYTES - 256;

__device__ __forceinline__ float bf2f(bf16 x) { return __uint_as_float(((unsigned)x) << 16); }
typedef __bf16 bf16x2_t __attribute__((ext_vector_type(2)));
__device__ __forceinline__ unsigned cvt_pk_bf16(float lo, float hi) { return __builtin_bit_cast(unsigned, __builtin_convertvector((f32x2){lo, hi}, bf16x2_t)); }
__device__ __forceinline__ unsigned pk2(float lo, float hi) { return cvt_pk_bf16(lo, hi); }
__device__ __forceinline__ unsigned pk4_f8(float a, float b, float c, float d) { int w = __builtin_amdgcn_cvt_pk_fp8_f32(a, b, 0, false); w = __builtin_amdgcn_cvt_pk_fp8_f32(c, d, w, true); return (unsigned)w; }
__device__ __forceinline__ unsigned f2bf(float f) { return cvt_pk_bf16(f, 0.f) & 0xffffu; }
__device__ __forceinline__ float sigmoidf_(float x) { return __builtin_amdgcn_rcpf(1.0f + __expf(-x)); }

__device__ __forceinline__ unsigned pk4_i8(float a, float b, float c, float d, float s) {
    const unsigned ua = __float_as_uint(__builtin_amdgcn_fmed3f(a * s, -127.f, 127.f) + 12582912.f), ub = __float_as_uint(__builtin_amdgcn_fmed3f(b * s, -127.f, 127.f) + 12582912.f);
    const unsigned uc = __float_as_uint(__builtin_amdgcn_fmed3f(c * s, -127.f, 127.f) + 12582912.f), ud = __float_as_uint(__builtin_amdgcn_fmed3f(d * s, -127.f, 127.f) + 12582912.f);
    return (ua & 0xffu) | ((ub & 0xffu) << 8) | ((uc & 0xffu) << 16) | (ud << 24);
}
constexpr float I8_MB = 127.f / 2.6f, I8_WOUT = 127.f / (4.f * 0.59460356f / 64.f), I8_DEQ_OUT = 1.f / (I8_MB * I8_WOUT);
constexpr float I8_CLIP = 4.f, I8_ACT = 127.f / I8_CLIP, I8_W = 127.f * 64.f / I8_CLIP, I8_DEQ = 1.f / (I8_ACT * I8_W);
namespace pg8 {
constexpr float W8SCALE_DN = 128.f;
constexpr float W8SCALE = 64.f;
constexpr int BM = 256, BK = 64, HALF = 128, HTB = HALF * BK * 2, STAGE_BYTES = 8 * HTB, NXCD = 8, WGM = 8;
__host__ __device__ __forceinline__ int lds_byte(int r, int c) { const int st = (r >> 4) * 2 + (c >> 5), rr = r & 15, cc = c & 31, ob = rr * 64 + cc * 2; return st * 1024 + (ob ^ (((ob >> 9) & 1) << 5)); }
__host__ __device__ __forceinline__ void stage_rc(int b, int& R, int& C) { const int st = b / 1024, sb = b % 1024, swz = sb ^ (((sb >> 9) & 1) << 5); R = (st >> 1) * 16 + swz / 64; C = (st & 1) * 32 + (swz % 64) / 2; }
__host__ __device__ __forceinline__ int perm32(int rho) { const int n = rho >> 4, i = rho & 15; return 8 * (i >> 2) + 4 * n + (i & 3); }
struct Unit { int pm, pn; };
struct Gemm { const bf16* A; const bf16* Bt; int M, N, K, lda, ldb; };
struct StaticOrder {
    int nM, nN, nwg, G, c, wgm;
    __device__ void init(int M, int N, int G_, int c_, int wgm_ = WGM) { nM = M / BM; nN = N / BM; nwg = nM * nN; G = G_; c = c_; wgm = wgm_; }
    __device__ bool next(int i, Unit& u) const {
        const long L = (long)i * G + c; if (L >= nwg) return false;
        int wgid = (int)L; { const int q = nwg / NXCD, r = nwg % NXCD, xcd = wgid % NXCD, off = wgid / NXCD; wgid = (xcd < r ? xcd * (q + 1) : r * (q + 1) + (xcd - r) * q) + off; }
        const int nig = wgm * nN, gid = wgid / nig, fm = gid * wgm, gsz = (nM - fm) < wgm ? (nM - fm) : wgm;
        u.pm = fm + ((wgid % nig) % gsz); u.pn = (wgid % nig) / gsz; return true;
    }
};
typedef int i32x8 __attribute__((ext_vector_type(8)));
typedef int i32x4 __attribute__((ext_vector_type(4)));
template <class T, class = void> struct IsI8 { static constexpr bool value = false; };
template <class T> struct IsI8<T, decltype((void)T::I8)> { static constexpr bool value = T::I8; };
template <class T, class = void> struct IsF8 { static constexpr bool value = false; };
template <class T> struct IsF8<T, decltype((void)T::F8)> { static constexpr bool value = T::F8; };
template <class T> __device__ __forceinline__ const T* sgpr_ptr(const T* p) { const unsigned long long v = (unsigned long long)p;
    const unsigned lo = __builtin_amdgcn_readfirstlane((unsigned)v), hi = __builtin_amdgcn_readfirstlane((unsigned)(v >> 32)); return (const T*)(((unsigned long long)hi << 32) | lo); }
template <class Epi>
__device__ __forceinline__ void gemm_phase(LAS unsigned char* lds, const Gemm g_in, const StaticOrder& S, const Epi& E) {
    Gemm g = g_in; g.A = sgpr_ptr(g_in.A); g.Bt = sgpr_ptr(g_in.Bt);
    int tid = threadIdx.x; asm volatile("" : "+v"(tid));
    const int wid = __builtin_amdgcn_readfirstlane(tid >> 6), lane = tid & 63, wr = wid >> 2, wc = wid & 3, fr = lane & 15, fq = lane >> 4;
    int nt = g.K / BK; asm volatile("" : "+s"(nt));
    unsigned voffA, voffB;
    { int R, C; stage_rc(tid * 16, R, C); const int Rb = Epi::PERM ? ((R & ~31) + perm32(R & 31)) : R;
      voffA = (unsigned)(R * g.lda + C) * 2u; voffB = (unsigned)(Rb * g.ldb + C) * 2u; }
    const size_t rsA = (size_t)64 * g.lda * 2, rsB = (size_t)64 * g.ldb * 2;
    const size_t kstep = (size_t)(BK * 2);
    const size_t hsA = (size_t)HALF * g.lda * 2, hsB = (size_t)HALF * g.ldb * 2, tsA = 2 * hsA, tsB = 2 * hsB;
    const unsigned ldsw = (unsigned)wid * 1024u;
    const int aoff = lds_byte(wr * 64 + fr, fq * 8), boff = lds_byte(wc * 32 + fr, fq * 8);
#define PG8_SA(b, h) (((b) * 2 + (h)) * HTB)
#define PG8_SB(b, h) ((4 + (b) * 2 + (h)) * HTB)
#define PG8_STAGE(bufoff, gbase, X) do { _Pragma("unroll") for (int _i = 0; _i < 2; ++_i) { \
        const char* gp_ = (const char*)(gbase) + (_i ? rs##X : (size_t)0); const unsigned la_ = (unsigned)(size_t)(lds + (bufoff) + ldsw + _i * 8192); \
        asm volatile("s_mov_b32 m0, %2\n\ts_nop 0\n\tglobal_load_lds_dwordx4 %0, %1" :: "v"(voff##X), "s"(gp_), "s"(la_) : "memory", "m0"); } } while (0)
#define PG8_LDA(dst, b, h) do { _Pragma("unroll") for (int m = 0; m < 4; ++m) _Pragma("unroll") for (int k = 0; k < 2; ++k) dst[m][k] = *(const LAS bf16x8*)(lds + PG8_SA(b, h) + aoff + m * 2048 + k * 1024); } while (0)
#define PG8_LDB(dst, b, h) do { _Pragma("unroll") for (int n = 0; n < 2; ++n) _Pragma("unroll") for (int k = 0; k < 2; ++k) dst[n][k] = *(const LAS bf16x8*)(lds + PG8_SB(b, h) + boff + n * 2048 + k * 1024); } while (0)
#ifdef F8_NMAJOR
#define F8_LOOP _Pragma("unroll") for (int n = 0; n < 2; ++n) _Pragma("unroll") for (int m = 0; m < 4; ++m)
#else
#define F8_LOOP _Pragma("unroll") for (int m = 0; m < 4; ++m) _Pragma("unroll") for (int n = 0; n < 2; ++n)
#endif
#define PG8_MMA(ai, bj, At, Bt) do { __builtin_amdgcn_s_setprio(1); \
        if constexpr (IsF8<Epi>::value) { i32x8 a8[4], b8[2]; \
            _Pragma("unroll") for (int m = 0; m < 4; ++m) a8[m] = __builtin_shufflevector(__builtin_bit_cast(i32x4, At[m][0]), __builtin_bit_cast(i32x4, At[m][1]), 0, 1, 2, 3, 4, 5, 6, 7); \
            _Pragma("unroll") for (int n = 0; n < 2; ++n) b8[n] = __builtin_shufflevector(__builtin_bit_cast(i32x4, Bt[n][0]), __builtin_bit_cast(i32x4, Bt[n][1]), 0, 1, 2, 3, 4, 5, 6, 7); \
            F8_LOOP asm volatile("v_mfma_f32_16x16x128_f8f6f4 %0, %1, %2, %0" : "+v"(acc[ai][bj][m][n]) : "v"(b8[n]), "v"(a8[m])); } \
        else if constexpr (IsI8<Epi>::value) { _Pragma("unroll") for (int m = 0; m < 4; ++m) _Pragma("unroll") for (int n = 0; n < 2; ++n) _Pragma("unroll") for (int k = 0; k < 2; ++k) \
            acc[ai][bj][m][n] = __builtin_bit_cast(f32x4, __builtin_amdgcn_mfma_i32_16x16x64_i8(__builtin_bit_cast(i32x4, Bt[n][k]), __builtin_bit_cast(i32x4, At[m][k]), __builtin_bit_cast(i32x4, acc[ai][bj][m][n]), 0, 0, 0)); } \
        else { _Pragma("unroll") for (int m = 0; m < 4; ++m) _Pragma("unroll") for (int n = 0; n < 2; ++n) _Pragma("unroll") for (int k = 0; k < 2; ++k) \
            acc[ai][bj][m][n] = __builtin_amdgcn_mfma_f32_16x16x32_bf16(Bt[n][k], At[m][k], acc[ai][bj][m][n], 0, 0, 0); } \
        __builtin_amdgcn_s_setprio(0); } while (0)
#define PG8_WAIT_V(n) asm volatile("s_waitcnt vmcnt(" #n ")" ::: "memory")
#define PG8_WAIT_L(n) asm volatile("s_waitcnt lgkmcnt(" #n ")" ::: "memory")
#define PG8_BAR __builtin_amdgcn_s_barrier()
#define PG8_SCHED __builtin_amdgcn_sched_barrier(0)
    Unit cur, nxt; int ui = 0;
    if (!S.next(0, cur)) return;
    f32x4 acc[2][2][4][2];
#pragma unroll
    for (int a = 0; a < 2; ++a)
#pragma unroll
        for (int b = 0; b < 2; ++b)
#pragma unroll
            for (int m = 0; m < 4; ++m)
#pragma unroll
                for (int n = 0; n < 2; ++n) acc[a][b][m][n] = (f32x4){0.f, 0.f, 0.f, 0.f};
    bf16x8 At[4][2], B0[2][2], B1[2][2];
    const char* cA = (const char*)g.A + (size_t)cur.pm * tsA; const char* cB = (const char*)g.Bt + (size_t)cur.pn * tsB;
    PG8_STAGE(PG8_SB(0, 0), cB, B); PG8_STAGE(PG8_SB(0, 1), cB + hsB, B); PG8_STAGE(PG8_SA(0, 0), cA, A); PG8_STAGE(PG8_SA(0, 1), cA + hsA, A);
    if (wr == 1) PG8_BAR;
    PG8_WAIT_V(2); PG8_BAR;
    PG8_STAGE(PG8_SB(1, 0), cB + kstep, B); PG8_STAGE(PG8_SA(1, 0), cA + kstep, A); PG8_STAGE(PG8_SB(1, 1), cB + hsB + kstep, B);
    PG8_WAIT_V(6); PG8_BAR;
    for (;;) {
        const bool has_next = S.next(ui + 1, nxt);
        const char* nA = has_next ? (const char*)g.A + (size_t)nxt.pm * tsA : cA; const char* nB = has_next ? (const char*)g.Bt + (size_t)nxt.pn * tsB : cB;
        for (int t = 0; t < nt; t += 2) {
            const bool last = (t == nt - 2);
            const char* a1 = cA + (size_t)(t + 1) * kstep;
            const char* a2 = last ? nA : cA + (size_t)(t + 2) * kstep; const char* b2 = last ? nB : cB + (size_t)(t + 2) * kstep;
            const char* a3 = a2 + kstep; const char* b3 = b2 + kstep;
            PG8_LDB(B0, 0, 0); PG8_LDB(B1, 0, 1); PG8_SCHED; PG8_LDA(At, 0, 0); PG8_STAGE(PG8_SA(1, 1), a1 + hsA, A);
            PG8_WAIT_V(8); PG8_WAIT_L(0); PG8_BAR; PG8_MMA(0, 0, At, B0); PG8_MMA(0, 1, At, B1); PG8_BAR; PG8_SCHED;
            PG8_LDA(At, 0, 1); PG8_STAGE(PG8_SB(0, 0), b2, B); PG8_STAGE(PG8_SB(0, 1), b2 + hsB, B); PG8_STAGE(PG8_SA(0, 0), a2, A);
            PG8_WAIT_V(8); PG8_WAIT_L(0); PG8_BAR; PG8_MMA(1, 0, At, B0); PG8_MMA(1, 1, At, B1); PG8_BAR; PG8_SCHED;
            PG8_LDB(B0, 1, 0); PG8_LDB(B1, 1, 1); PG8_SCHED; PG8_LDA(At, 1, 0); PG8_STAGE(PG8_SA(0, 1), a2 + hsA, A);
            PG8_WAIT_V(8); PG8_WAIT_L(0); PG8_BAR; PG8_MMA(0, 0, At, B0); PG8_MMA(0, 1, At, B1); PG8_BAR; PG8_SCHED;
            PG8_LDA(At, 1, 1); PG8_STAGE(PG8_SB(1, 0), b3, B); PG8_STAGE(PG8_SB(1, 1), b3 + hsB, B); PG8_STAGE(PG8_SA(1, 0), a3, A);
            PG8_WAIT_V(8); PG8_WAIT_L(0); PG8_BAR; PG8_MMA(1, 0, At, B0); PG8_MMA(1, 1, At, B1); PG8_BAR; PG8_SCHED;
        }
        if (wr == 0) PG8_BAR;
        if constexpr (IsF8<Epi>::value) asm volatile("s_nop 15\n\ts_nop 15" ::: "memory");
        E(acc, cur, wr, wc, fr, fq);
        if (!has_next) break;
#pragma unroll
        for (int a = 0; a < 2; ++a)
#pragma unroll
            for (int b = 0; b < 2; ++b)
#pragma unroll
                for (int m = 0; m < 4; ++m)
#pragma unroll
                    for (int n = 0; n < 2; ++n) acc[a][b][m][n] = (f32x4){0.f, 0.f, 0.f, 0.f};
        cur = nxt; cA = nA; cB = nB; ++ui;
        if (wr == 1) PG8_BAR;
    }
    PG8_WAIT_V(0);
    PG8_BAR;
#undef PG8_SA
#undef PG8_SB
#undef PG8_STAGE
#undef PG8_LDA
#undef PG8_LDB
#undef PG8_MMA
#undef PG8_WAIT_V
#undef PG8_WAIT_L
#undef PG8_BAR
#undef PG8_SCHED
}

template <int IN, bool OUT8> struct EpiSwiGLU {
    static constexpr bool PERM = true, F8 = (IN == 1), I8 = (IN == 2);
    bf16* H;
    __device__ __forceinline__ void operator()(const f32x4 (&acc)[2][2][4][2], const Unit& u, int wr, int wc, int fr, int fq) const {
        asm volatile("" : "+v"(fr), "+v"(fq));
        const int row0 = u.pm * BM + wr * 64 + fr, col0 = u.pn * 128 + wc * 32 + 8 * fq;
#pragma unroll
        for (int ai = 0; ai < 2; ++ai)
#pragma unroll
            for (int m = 0; m < 4; ++m) { bf16* rowp = H + (size_t)(row0 + ai * HALF + m * 16) * DFF + col0;
                float h[8];
#pragma unroll
                for (int n = 0; n < 2; ++n)
#pragma unroll
                    for (int j = 0; j < 4; ++j) { const float ga = acc[ai][0][m][n][j], ua = acc[ai][1][m][n][j];
                        const float gt = IN == 2 ? (float)__float_as_int(ga) * I8_DEQ : (IN == 1 ? ga * (1.f / W8SCALE) : ga), up = IN == 2 ? (float)__float_as_int(ua) * I8_DEQ : (IN == 1 ? ua * (1.f / W8SCALE) : ua); h[n * 4 + j] = gt * sigmoidf_(gt) * up; }
                if (OUT8) *(u32x2*)((unsigned char*)H + (size_t)(row0 + ai * HALF + m * 16) * DFF + col0) = (u32x2){pk4_f8(h[0], h[1], h[2], h[3]), pk4_f8(h[4], h[5], h[6], h[7])};
                else { u32x4 w; w.x = cvt_pk_bf16(h[0], h[1]); w.y = cvt_pk_bf16(h[2], h[3]); w.z = cvt_pk_bf16(h[4], h[5]); w.w = cvt_pk_bf16(h[6], h[7]);
                    *(u32x4*)rowp = w; } }
    }
};
template <bool SPLIT, int IN = 0> struct EpiResid {
    static constexpr bool PERM = true, F8 = (IN == 1), I8 = (IN == 2);
    bf16* out; const float* xp; const float* xs; const bf16* xb; float scale;
    __device__ __forceinline__ void operator()(const f32x4 (&acc)[2][2][4][2], const Unit& u, int wr, int wc, int fr, int fq) const {
        const int row0 = u.pm * BM + wr * 64 + fr, col0 = u.pn * BM + wc * 32 + 8 * fq;
#pragma unroll
        for (int ai = 0; ai < 2; ++ai) {
            if (u.pm * BM + ai * HALF < MR) {
                f32x4 bv[4][2][2];
#pragma unroll
                for (int m = 0; m < 4; ++m) { const int row = row0 + ai * HALF + m * 16;
                    if (SPLIT) { const float* bp = row < MPR ? xp + (size_t)row * D + col0 : xs + (size_t)(row - MPR) * D + col0;
#pragma unroll
                        for (int bj = 0; bj < 2; ++bj)
#pragma unroll
                            for (int n = 0; n < 2; ++n) bv[m][bj][n] = *(const f32x4*)(bp + bj * HALF + n * 4);
                    } else { const bf16* bp = xb + (size_t)row * D + col0;
#pragma unroll
                        for (int bj = 0; bj < 2; ++bj) { const u32x4 w = *(const u32x4*)(bp + bj * HALF);
                            bv[m][bj][0] = (f32x4){__uint_as_float(w.x << 16), __uint_as_float(w.x & 0xffff0000u), __uint_as_float(w.y << 16), __uint_as_float(w.y & 0xffff0000u)};
                            bv[m][bj][1] = (f32x4){__uint_as_float(w.z << 16), __uint_as_float(w.z & 0xffff0000u), __uint_as_float(w.w << 16), __uint_as_float(w.w & 0xffff0000u)}; } } }
#pragma unroll
                for (int m = 0; m < 4; ++m) { bf16* op = out + (size_t)(row0 + ai * HALF + m * 16) * D + col0;
#pragma unroll
                    for (int bj = 0; bj < 2; ++bj) { f32x4 a0 = acc[ai][bj][m][0], a1 = acc[ai][bj][m][1];
                        if (IN == 2) { a0 = __builtin_convertvector(__builtin_bit_cast(i32x4, a0), f32x4); a1 = __builtin_convertvector(__builtin_bit_cast(i32x4, a1), f32x4); }
                        const f32x4 v0 = bv[m][bj][0] * ALPHA + a0 * scale, v1 = bv[m][bj][1] * ALPHA + a1 * scale;
                        u32x4 w; w.x = cvt_pk_bf16(v0[0], v0[1]); w.y = cvt_pk_bf16(v0[2], v0[3]); w.z = cvt_pk_bf16(v1[0], v1[1]); w.w = cvt_pk_bf16(v1[2], v1[3]);
                        *(u32x4*)(op + bj * HALF) = w; } }
            } }
    }
};
struct EpiZ {
    static constexpr bool PERM = true;
    bf16 *zh, *zr, *zg;
    __device__ __forceinline__ void operator()(const f32x4 (&acc)[2][2][4][2], const Unit& u, int wr, int wc, int fr, int fq) const {
        bf16* base; int ld, colt;
        if (u.pn < 32) { base = zh; ld = LDZH; colt = u.pn * BM; } else if (u.pn < 59) { base = zr; ld = LDZR; colt = (u.pn - 32) * BM; } else { base = zg; ld = LDZG; colt = (u.pn - 59) * BM; }
        const int row0 = u.pm * BM + wr * 64 + fr, col0 = colt + wc * 32 + 8 * fq;
#pragma unroll
        for (int ai = 0; ai < 2; ++ai)
#pragma unroll
            for (int m = 0; m < 4; ++m) { bf16* rowp = base + (size_t)(row0 + ai * HALF + m * 16) * ld + col0;
#pragma unroll
                for (int bj = 0; bj < 2; ++bj) { const f32x4 v0 = acc[ai][bj][m][0], v1 = acc[ai][bj][m][1];
                    u32x4 w; w.x = cvt_pk_bf16(v0[0], v0[1]); w.y = cvt_pk_bf16(v0[2], v0[3]); w.z = cvt_pk_bf16(v1[0], v1[1]); w.w = cvt_pk_bf16(v1[2], v1[3]);
                    *(u32x4*)(rowp + bj * HALF) = w; } }
    }
};
template <bool I8_> struct EpiZr {
    static constexpr bool PERM = true, I8 = I8_;
    bf16 *zh, *zr, *zg;
    __device__ __forceinline__ void operator()(const f32x4 (&acc)[2][2][4][2], const Unit& u, int wr, int wc, int fr, int fq) const {
        asm volatile("" : "+v"(fr), "+v"(fq));
        bf16* base; int ld, colt; const int pn = u.pn;
        if (!I8_) { if (pn < 16) { base = zh; ld = LDZH; colt = (pn + 8) * BM; } else { base = zr; ld = LDZR; colt = (pn - 8) * BM; } }
        else { if (pn < 32) { base = zg; ld = LDZG; colt = pn * BM; } else if (pn < 40) { base = zh; ld = LDZH; colt = (pn - 32) * BM; } else if (pn < 48) { base = zh; ld = LDZH; colt = (pn - 16) * BM; } else { base = zr; ld = LDZR; colt = (pn - 48) * BM; } }
        const int row0 = u.pm * BM + wr * 64 + fr, col0 = colt + wc * 32 + 8 * fq;
#pragma unroll
        for (int ai = 0; ai < 2; ++ai)
#pragma unroll
            for (int m = 0; m < 4; ++m) { bf16* rowp = base + (size_t)(row0 + ai * HALF + m * 16) * ld + col0;
#pragma unroll
                for (int bj = 0; bj < 2; ++bj) { f32x4 v0 = acc[ai][bj][m][0], v1 = acc[ai][bj][m][1];
                    if (I8_) { v0 = __builtin_convertvector(__builtin_bit_cast(i32x4, v0), f32x4) * I8_DEQ; v1 = __builtin_convertvector(__builtin_bit_cast(i32x4, v1), f32x4) * I8_DEQ; }
                    u32x4 w; w.x = cvt_pk_bf16(v0[0], v0[1]); w.y = cvt_pk_bf16(v0[2], v0[3]); w.z = cvt_pk_bf16(v1[0], v1[1]); w.w = cvt_pk_bf16(v1[2], v1[3]);
                    *(u32x4*)(rowp + bj * HALF) = w; } }
    }
};
struct EpiZG8 {
    static constexpr bool PERM = true, I8 = true;
    bf16* zg;
    __device__ __forceinline__ void operator()(const f32x4 (&acc)[2][2][4][2], const Unit& u, int wr, int wc, int fr, int fq) const {
        asm volatile("" : "+v"(fr), "+v"(fq));
        const int row0 = u.pm * BM + wr * 64 + fr, col0 = u.pn * BM + wc * 32 + 8 * fq;
#pragma unroll
        for (int ai = 0; ai < 2; ++ai)
#pragma unroll
            for (int m = 0; m < 4; ++m) { bf16* rowp = zg + (size_t)(row0 + ai * HALF + m * 16) * LDZG + col0;
#pragma unroll
                for (int bj = 0; bj < 2; ++bj) { const f32x4 v0 = __builtin_convertvector(__builtin_bit_cast(i32x4, acc[ai][bj][m][0]), f32x4) * I8_DEQ, v1 = __builtin_convertvector(__builtin_bit_cast(i32x4, acc[ai][bj][m][1]), f32x4) * I8_DEQ;
                    u32x4 w; w.x = cvt_pk_bf16(v0[0], v0[1]); w.y = cvt_pk_bf16(v0[2], v0[3]); w.z = cvt_pk_bf16(v1[0], v1[1]); w.w = cvt_pk_bf16(v1[2], v1[3]);
                    *(u32x4*)(rowp + bj * HALF) = w; } }
    }
};
struct EpiLoraF32 {
    static constexpr bool PERM = true;
    bf16* out; const float* bias;
    __device__ __forceinline__ void operator()(const f32x4 (&acc)[2][2][4][2], const Unit& u, int wr, int wc, int fr, int fq) const {
        const int row0 = u.pm * BM + wr * 64 + fr, col0 = u.pn * BM + wc * 32 + 8 * fq;
#pragma unroll
        for (int bj = 0; bj < 2; ++bj) { const f32x4 b0 = *(const f32x4*)(bias + col0 + bj * HALF), b1 = *(const f32x4*)(bias + col0 + bj * HALF + 4);
#pragma unroll
            for (int ai = 0; ai < 2; ++ai)
#pragma unroll
                for (int m = 0; m < 4; ++m) { const f32x4 v0 = acc[ai][bj][m][0] + b0, v1 = acc[ai][bj][m][1] + b1;
                    u32x4 w; w.x = cvt_pk_bf16(v0[0], v0[1]); w.y = cvt_pk_bf16(v0[2], v0[3]); w.z = cvt_pk_bf16(v1[0], v1[1]); w.w = cvt_pk_bf16(v1[2], v1[3]);
                    *(u32x4*)(out + (size_t)(row0 + ai * HALF + m * 16) * DH + col0 + bj * HALF) = w; } }
    }
};
struct EpiBf16Plain {
    static constexpr bool PERM = true;
    bf16* O; int ldc;
    __device__ __forceinline__ void operator()(const f32x4 (&acc)[2][2][4][2], const Unit& u, int wr, int wc, int fr, int fq) const {
        const int row0 = u.pm * BM + wr * 64 + fr, col0 = u.pn * BM + wc * 32 + 8 * fq;
#pragma unroll
        for (int ai = 0; ai < 2; ++ai)
#pragma unroll
            for (int m = 0; m < 4; ++m) { bf16* rowp = O + (size_t)(row0 + ai * HALF + m * 16) * ldc + col0;
#pragma unroll
                for (int bj = 0; bj < 2; ++bj) { const f32x4 v0 = acc[ai][bj][m][0], v1 = acc[ai][bj][m][1];
                    u32x4 w; w.x = cvt_pk_bf16(v0[0], v0[1]); w.y = cvt_pk_bf16(v0[2], v0[3]); w.z = cvt_pk_bf16(v1[0], v1[1]); w.w = cvt_pk_bf16(v1[2], v1[3]);
                    *(u32x4*)(rowp + bj * HALF) = w; } }
    }
};
template <bool FIRST> struct EpiProj {
    static constexpr bool PERM = true;
    bf16* mb; const bf16* zg; int goff; unsigned char* m8;
    __device__ __forceinline__ void operator()(const f32x4 (&acc)[2][2][4][2], const Unit& u, int wr, int wc, int fr, int fq) const {
        const int row0 = u.pm * BM + wr * 64 + fr, col0 = u.pn * BM + wc * 32 + 8 * fq;
#pragma unroll
        for (int ai = 0; ai < 2; ++ai) {
            u32x4 gw[4][2], pw[4][2];
#pragma unroll
            for (int m = 0; m < 4; ++m) { const size_t r = (size_t)(row0 + ai * HALF + m * 16);
#pragma unroll
                for (int bj = 0; bj < 2; ++bj) { gw[m][bj] = *(const u32x4*)(zg + r * LDZG + goff + col0 + bj * HALF);
                    pw[m][bj] = (u32x4){0u, 0u, 0u, 0u}; if (!FIRST) pw[m][bj] = *(const u32x4*)(mb + r * D + col0 + bj * HALF); } }
#pragma unroll
            for (int m = 0; m < 4; ++m) { const size_t r = (size_t)(row0 + ai * HALF + m * 16);
#pragma unroll
                for (int bj = 0; bj < 2; ++bj) {
                    float o[8];
#pragma unroll
                    for (int q = 0; q < 4; ++q) { const unsigned gq = gw[m][bj][q], pq = pw[m][bj][q];
                        const float g0 = __uint_as_float(gq << 16), g1 = __uint_as_float(gq & 0xffff0000u), p0 = __uint_as_float(pq << 16), p1 = __uint_as_float(pq & 0xffff0000u);
                        const f32x4 a = acc[ai][bj][m][q >> 1]; const float a0 = a[(q & 1) * 2], a1 = a[(q & 1) * 2 + 1];
                        o[2 * q] = p0 + sigmoidf_(g0) * a0; o[2 * q + 1] = p1 + sigmoidf_(g1) * a1; }
                    if (FIRST) { u32x4 w; w.x = cvt_pk_bf16(o[0], o[1]); w.y = cvt_pk_bf16(o[2], o[3]); w.z = cvt_pk_bf16(o[4], o[5]); w.w = cvt_pk_bf16(o[6], o[7]);
                        *(u32x4*)(mb + r * D + col0 + bj * HALF) = w; }
                    else *(u32x2*)(m8 + r * D + col0 + bj * HALF) = (u32x2){pk4_i8(o[0], o[1], o[2], o[3], I8_MB), pk4_i8(o[4], o[5], o[6], o[7], I8_MB)}; } }
        }
    }
};
}
using pg8::i32x4;

template <int MODE = 0, class EpiE>
__device__ __forceinline__ void skinny_phase(LAS unsigned char* lds, const bf16* A, int lda, const bf16* Bt, int ldb, int K, const EpiE& epi) {
    int tid = threadIdx.x; asm volatile("" : "+v"(tid));
    const int w = __builtin_amdgcn_readfirstlane(tid >> 6), lane = tid & 63, fr = lane & 15, fq = lane >> 4;
    const int kw = K / 8;
    for (int pc = blockIdx.x; pc < 256; pc += gridDim.x) {
        const int rg = (pc >> 3) & 3, cg = (pc & 7) * 8 + (pc >> 5);
        const bf16* ap = A + (size_t)(MPR + 32 * rg + fr) * lda + w * kw + 8 * fq;
        const bf16* bp = Bt + (size_t)(64 * cg + fr) * ldb + w * kw + 8 * fq;
        const unsigned char* ap8 = (const unsigned char*)A + (size_t)(MPR + 32 * rg + fr) * lda + w * kw + 8 * fq;
        const unsigned char* bp8 = (const unsigned char*)Bt + (size_t)(64 * cg + fr) * ldb + w * kw + 8 * fq;
        f32x4 acc[2][4];
#pragma unroll
        for (int mt = 0; mt < 2; ++mt)
#pragma unroll
            for (int nt = 0; nt < 4; ++nt) acc[mt][nt] = (f32x4){0.f, 0.f, 0.f, 0.f};
#pragma unroll 4
        for (int k0 = 0; k0 < kw; k0 += 32) {
            if constexpr (MODE == 2) { if (k0 & 32) continue;
                i32x4 ai[2], bi[4];
#pragma unroll
                for (int mt = 0; mt < 2; ++mt) ai[mt] = *(const i32x4*)(ap8 + (size_t)(16 * mt) * lda + k0 + 8 * fq);
#pragma unroll
                for (int nt = 0; nt < 4; ++nt) bi[nt] = *(const i32x4*)(bp8 + (size_t)(16 * nt) * ldb + k0 + 8 * fq);
#pragma unroll
                for (int mt = 0; mt < 2; ++mt)
#pragma unroll
                    for (int nt = 0; nt < 4; ++nt) acc[mt][nt] = __builtin_bit_cast(f32x4, __builtin_amdgcn_mfma_i32_16x16x64_i8(bi[nt], ai[mt], __builtin_bit_cast(i32x4, acc[mt][nt]), 0, 0, 0));
                continue; }
            if constexpr (MODE == 1) { long a8[2], b8[4];
#pragma unroll
                for (int mt = 0; mt < 2; ++mt) a8[mt] = *(const long*)(ap8 + (size_t)(16 * mt) * lda + k0);
#pragma unroll
                for (int nt = 0; nt < 4; ++nt) b8[nt] = *(const long*)(bp8 + (size_t)(16 * nt) * ldb + k0);
#pragma unroll
                for (int mt = 0; mt < 2; ++mt)
#pragma unroll
                    for (int nt = 0; nt < 4; ++nt) acc[mt][nt] = __builtin_amdgcn_mfma_f32_16x16x32_fp8_fp8(b8[nt], a8[mt], acc[mt][nt], 0, 0, 0);
                continue; }
            bf16x8 af[2], bfr[4];
#pragma unroll
            for (int mt = 0; mt < 2; ++mt) af[mt] = *(const bf16x8*)(ap + (size_t)(16 * mt) * lda + k0);
#pragma unroll
            for (int nt = 0; nt < 4; ++nt) bfr[nt] = *(const bf16x8*)(bp + (size_t)(16 * nt) * ldb + k0);
#pragma unroll
            for (int mt = 0; mt < 2; ++mt)
#pragma unroll
                for (int nt = 0; nt < 4; ++nt) acc[mt][nt] = __builtin_amdgcn_mfma_f32_16x16x32_bf16(bfr[nt], af[mt], acc[mt][nt], 0, 0, 0);
        }
        if constexpr (MODE == 2) {
#pragma unroll
            for (int mt = 0; mt < 2; ++mt)
#pragma unroll
                for (int nt = 0; nt < 4; ++nt) acc[mt][nt] = __builtin_convertvector(__builtin_bit_cast(i32x4, acc[mt][nt]), f32x4); }
        LAS float* red = (LAS float*)(lds + w * 8192);
#pragma unroll
        for (int mt = 0; mt < 2; ++mt)
#pragma unroll
            for (int nt = 0; nt < 4; ++nt) *(LAS f32x4*)(red + (16 * mt + fr) * 64 + 16 * nt + 4 * fq) = acc[mt][nt];
        __syncthreads();
        { const int m = tid >> 4, n4 = (tid & 15) * 4; f32x4 sum = (f32x4){0.f, 0.f, 0.f, 0.f};
#pragma unroll
          for (int ww = 0; ww < 8; ++ww) sum = sum + *(const LAS f32x4*)((const LAS float*)(lds + ww * 8192) + m * 64 + n4);
          epi(MPR + 32 * rg + m, 64 * cg + n4, sum); }
        __syncthreads();
    }
}
struct SkResidSplit { bf16* out; const float* xs; float scale;
    __device__ __forceinline__ void operator()(int row, int col, f32x4 a) const { const f32x4 b = *(const f32x4*)(xs + (size_t)(row - MPR) * D + col); const f32x4 t = b * ALPHA + a * scale;
        *(u32x2*)(out + (size_t)row * D + col) = (u32x2){pk2(t[0], t[1]), pk2(t[2], t[3])}; } };
struct SkResidBf { bf16* out; const bf16* xb; float scale;
    __device__ __forceinline__ void operator()(int row, int col, f32x4 a) const { const u32x2 w = *(const u32x2*)(xb + (size_t)row * D + col);
        const f32x4 b = (f32x4){__uint_as_float(w.x << 16), __uint_as_float(w.x & 0xffff0000u), __uint_as_float(w.y << 16), __uint_as_float(w.y & 0xffff0000u)}; const f32x4 t = b * ALPHA + a * scale;
        *(u32x2*)(out + (size_t)row * D + col) = (u32x2){pk2(t[0], t[1]), pk2(t[2], t[3])}; } };
template <bool FIRST> struct SkProj { bf16* mb; const bf16* zg; int goff; unsigned char* m8;
    __device__ __forceinline__ void operator()(int row, int col, f32x4 a) const {
        const u32x2 gw = *(const u32x2*)(zg + (size_t)row * LDZG + goff + col); u32x2 pw = (u32x2){0u, 0u}; if (!FIRST) pw = *(const u32x2*)(mb + (size_t)row * D + col);
        const float g0 = __uint_as_float(gw.x << 16), g1 = __uint_as_float(gw.x & 0xffff0000u), g2 = __uint_as_float(gw.y << 16), g3 = __uint_as_float(gw.y & 0xffff0000u);
        const float p0 = __uint_as_float(pw.x << 16), p1 = __uint_as_float(pw.x & 0xffff0000u), p2 = __uint_as_float(pw.y << 16), p3 = __uint_as_float(pw.y & 0xffff0000u);
        const float o0 = p0 + sigmoidf_(g0) * a[0], o1 = p1 + sigmoidf_(g1) * a[1], o2 = p2 + sigmoidf_(g2) * a[2], o3 = p3 + sigmoidf_(g3) * a[3];
        if (FIRST) *(u32x2*)(mb + (size_t)row * D + col) = (u32x2){pk2(o0, o1), pk2(o2, o3)};
        else *(unsigned*)(m8 + (size_t)row * D + col) = pk4_i8(o0, o1, o2, o3, I8_MB); } };

#define XB_TMO      128
#define XB_XCNT(j)  (256  + 64 * (j))
#define XB_XSUB(j)  (1280 + 64 * (j))
#define XB_XGEN(j)  (2304 + 64 * (j))
#define XB_TOP      3328
#define XB_TOPGEN   3392
#define XCD_BAR_WORDS 3456
#define XB_SPIN_CAP (1u << 20)
__device__ __forceinline__ unsigned xb_ld(unsigned* p)              { return __hip_atomic_load(p, __ATOMIC_RELAXED, __HIP_MEMORY_SCOPE_AGENT); }
__device__ __forceinline__ unsigned xb_add(unsigned* p, unsigned v) { return __hip_atomic_fetch_add(p, v, __ATOMIC_RELAXED, __HIP_MEMORY_SCOPE_AGENT); }
__device__ __forceinline__ unsigned xb_xcc_id() { return (unsigned)__builtin_amdgcn_s_getreg((3 << 11) | 20) & 0xFu; }
#define XB_SPIN(cond, bar) do { unsigned _sp = 0; while (cond) { __builtin_amdgcn_s_sleep(1); \
    if ((++_sp & 255u) == 0u) { if (xb_ld(&(bar)[XB_TMO])) break; if (_sp > XB_SPIN_CAP) { atomicAdd(&(bar)[XB_TMO], 1u); break; } } } } while (0)
struct XcdBarrier { unsigned* bar; unsigned x; volatile LAS unsigned* st; };
__device__ __forceinline__ XcdBarrier xcd_barrier_post(unsigned* bar, volatile LAS unsigned* st) {
    XcdBarrier b; b.bar = bar; b.x = xb_xcc_id(); b.st = st;
    if (threadIdx.x == 0) (void)xb_add(&bar[XB_XCNT(b.x)], 1u);
    return b;
}
__device__ __forceinline__ void xcd_barrier_complete(unsigned* bar, unsigned x, unsigned& nloc, unsigned& nx) {
    const unsigned G = gridDim.x * gridDim.y * gridDim.z;
    unsigned sum, cnt, mine, sp = 0u;
    for (;;) {
        sum = 0u; cnt = 0u; mine = 0u;
#pragma unroll
        for (unsigned j = 0; j < 16; ++j) { const unsigned c = xb_ld(&bar[XB_XCNT(j)]); sum += c; cnt += (c > 0u) ? 1u : 0u; mine = (j == x) ? c : mine; }
        if (sum == G) break;
        __builtin_amdgcn_s_sleep(1);
        if ((++sp & 255u) == 0u) { if (xb_ld(&bar[XB_TMO])) break; if (sp > XB_SPIN_CAP) { atomicAdd(&bar[XB_TMO], 1u); break; } }
    }
    nloc = mine > 0u ? mine : 1u; nx = cnt > 0u ? cnt : 1u;
}
__device__ __forceinline__ void xcd_barrier(const XcdBarrier& b) {
    asm volatile("s_waitcnt vmcnt(0)" ::: "memory");
    __syncthreads();
    if (threadIdx.x == 0) {
        unsigned* bar = b.bar;
        __builtin_amdgcn_s_waitcnt(0);
        unsigned nloc = b.st[0], nx = b.st[1];
        if (nloc == 0u) { xcd_barrier_complete(bar, b.x, nloc, nx); b.st[0] = nloc; b.st[1] = nx; }
        const unsigned old = xb_add(&bar[XB_XSUB(b.x)], 1u);
        const unsigned gen = old / nloc;
        if (old + 1u == (gen + 1u) * nloc) {
            __builtin_amdgcn_fence(__ATOMIC_RELEASE, "agent");
            asm volatile("s_waitcnt vmcnt(0)" ::: "memory");
            const unsigned og = xb_add(&bar[XB_TOP], 1u);
            const unsigned tg = og / nx;
            if (og + 1u == (tg + 1u) * nx) xb_add(&bar[XB_TOPGEN], 1u);
            else XB_SPIN(xb_ld(&bar[XB_TOPGEN]) == tg, bar);
            __builtin_amdgcn_fence(__ATOMIC_ACQUIRE, "agent");
            xb_add(&bar[XB_XGEN(b.x)], 1u);
            asm volatile("s_waitcnt vmcnt(0)" ::: "memory");
        } else {
            XB_SPIN(xb_ld(&bar[XB_XGEN(b.x)]) == gen, bar);
            __builtin_amdgcn_fence(__ATOMIC_ACQUIRE, "agent");
            asm volatile("s_waitcnt vmcnt(0)" ::: "memory");
        }
    }
    __syncthreads();
}

struct Params {
    const float* in[32];
    float* out; unsigned char* ws;
};
struct Frame {
    LAS unsigned char* lds;
    int tid, lane, wave, G, gw, NGW;
    const float* const* in; float* out; unsigned char* ws;
};
#define LDS_WAIT() asm volatile("s_waitcnt lgkmcnt(0)" ::: "memory")
__device__ __forceinline__ float wave_sum(float v) {
#pragma unroll
    for (int o = 1; o < 64; o <<= 1) v += __shfl_xor(v, o);
    return v;
}
enum { I_XP = 0, I_XS, I_SHG, I_SRW, I_SSH, I_LN1G, I_LN1B, I_F1IN, I_F1DN, I_LN2G, I_LN2B, I_WIN, I_HGLB, I_HGNG, I_HGPROJ, I_MU, I_W0, I_W2, I_A0, I_A2, I_G2,
       I_KK, I_KA, I_RK, I_LNG, I_LNB, I_RWPROJ, I_WOUT, I_LN3G, I_LN3B, I_F2IN, I_F2DN };

template <int MAP>
__device__ __forceinline__ void transpose_item(const float* W, int K, int N, int ldw, bf16* WT, LAS float* scr, int item, int lane) {
    const int nblk = N / 32, kb = item / nblk, nb = item % nblk, k0 = 64 * kb, n0 = 32 * nb;
    int dr0 = n0;
    if (MAP == 1) { if (n0 < DFF) dr0 = (n0 >> 7) * 256 + (n0 & 127); else { const int uo = n0 - DFF; dr0 = (uo >> 7) * 256 + 128 + (uo & 127); } }
#pragma unroll 8
    for (int i = 0; i < 32; ++i) { const int kk = 2 * i + (lane >> 5); scr[kk * 33 + (lane & 31)] = W[(size_t)(k0 + kk) * ldw + n0 + (lane & 31)]; }
    LDS_WAIT(); asm volatile("" ::: "memory");
    const int c = lane & 7;
#pragma unroll
    for (int j = 0; j < 4; ++j) { const int n = (lane >> 3) + 8 * j; const LAS float* s = scr + (8 * c) * 33 + n;
        u32x4 o; o.x = pk2(s[0 * 33], s[1 * 33]); o.y = pk2(s[2 * 33], s[3 * 33]); o.z = pk2(s[4 * 33], s[5 * 33]); o.w = pk2(s[6 * 33], s[7 * 33]);
        *(u32x4*)(WT + (size_t)(dr0 + n) * K + k0 + 8 * c) = o; }
    LDS_WAIT(); asm volatile("" ::: "memory");
}
template <int MAP, bool QI8 = false>
__device__ __forceinline__ void transpose_f8_matrix(Frame& F, const float* W, int K, int N, unsigned char* WT, float scl, int ldw = 0) {
    if (ldw == 0) ldw = N;
    LAS float* scr = (LAS float*)(F.lds + F.wave * 16384); const int lane = F.lane;
    const int nblk = N / 32, nitems = (K / 64) * nblk;
    for (int item = F.gw; item < nitems; item += F.NGW) { const int kb = item / nblk, nb = item % nblk, k0 = 64 * kb, n0 = 32 * nb;
        int dr0 = n0; if (MAP == 1) { if (n0 < DFF) dr0 = (n0 >> 7) * 256 + (n0 & 127); else { const int uo = n0 - DFF; dr0 = (uo >> 7) * 256 + 128 + (uo & 127); } }
#pragma unroll 8
        for (int i = 0; i < 32; ++i) { const int kk = 2 * i + (lane >> 5); scr[kk * 33 + (lane & 31)] = W[(size_t)(k0 + kk) * ldw + n0 + (lane & 31)]; }
        LDS_WAIT(); asm volatile("" ::: "memory");
        const int c = lane & 3;
#pragma unroll
        for (int j = 0; j < 2; ++j) { const int n = (lane >> 2) + 16 * j; const LAS float* sp = scr + (16 * c) * 33 + n;
            u32x4 o;
            if (QI8) { o.x = pk4_i8(sp[0 * 33], sp[1 * 33], sp[2 * 33], sp[3 * 33], scl); o.y = pk4_i8(sp[4 * 33], sp[5 * 33], sp[6 * 33], sp[7 * 33], scl);
                o.z = pk4_i8(sp[8 * 33], sp[9 * 33], sp[10 * 33], sp[11 * 33], scl); o.w = pk4_i8(sp[12 * 33], sp[13 * 33], sp[14 * 33], sp[15 * 33], scl); }
            else {
            o.x = pk4_f8(sp[0 * 33] * scl, sp[1 * 33] * scl, sp[2 * 33] * scl, sp[3 * 33] * scl); o.y = pk4_f8(sp[4 * 33] * scl, sp[5 * 33] * scl, sp[6 * 33] * scl, sp[7 * 33] * scl);
            o.z = pk4_f8(sp[8 * 33] * scl, sp[9 * 33] * scl, sp[10 * 33] * scl, sp[11 * 33] * scl); o.w = pk4_f8(sp[12 * 33] * scl, sp[13 * 33] * scl, sp[14 * 33] * scl, sp[15 * 33] * scl); }
            *(u32x4*)(WT + (size_t)(dr0 + n) * K + k0 + 16 * c) = o; }
        LDS_WAIT(); asm volatile("" ::: "memory"); }
}
template <int MAP>
__device__ __forceinline__ void transpose_matrix(Frame& F, const float* W, int K, int N, bf16* WT, int ldw = 0) {
    LAS float* scr = (LAS float*)(F.lds + F.wave * 16384); if (ldw == 0) ldw = N;
    const int nitems = (K / 64) * (N / 32);
    for (int it = F.gw; it < nitems; it += F.NGW) transpose_item<MAP>(W, K, N, ldw, WT, scr, it, F.lane);
}
__device__ __forceinline__ void lora_weight(Frame& F, const float* W, int KR, int KP, bf16* dst) {
    const int total = 2048 * KP; const int gt = blockIdx.x * 512 + F.tid, NT = F.G * 512;
    for (int e = gt; e < total; e += NT) { const int n = e / KP, k = e % KP; dst[e] = (bf16)(k < KR ? f2bf(W[(size_t)k * 2048 + n]) : 0u); }
}
__device__ __forceinline__ void p0_prologue(Frame& F) {
    { unsigned char* x8 = F.ws + WS_XB8; const float* xp = F.in[I_XP]; const float* xs = F.in[I_XS];
      const size_t total8 = (size_t)MP * D / 8; const size_t gt = (size_t)blockIdx.x * 512 + F.tid, NT = (size_t)F.G * 512;
      for (size_t e = gt; e < total8; e += NT) { const size_t el = e * 8; const int row = (int)(el / D);
          u32x2 o = (u32x2){0u, 0u};
          if (row < MR) { const float* src = row < MPR ? xp + el : xs + (el - (size_t)MPR * D); const f32x4 a = *(const f32x4*)src, b = *(const f32x4*)(src + 4);
              o.x = pk4_i8(a[0], a[1], a[2], a[3], I8_ACT); o.y = pk4_i8(b[0], b[1], b[2], b[3], I8_ACT); }
          *(u32x2*)(x8 + el) = o; } }
    transpose_f8_matrix<1, true>(F, F.in[I_F1IN], D, NFF, F.ws + WS_WFI, I8_W);
    transpose_f8_matrix<0>(F, F.in[I_F1DN], DFF, D, F.ws + WS_WFD, pg8::W8SCALE_DN);
    { const int ldw = 8192 + DRIN + 8192; const float* W = F.in[I_WIN]; bf16* wb = (bf16*)(F.ws + WS_WIN); unsigned char* w8 = F.ws + WS_WIN8;
      transpose_matrix<0>(F, W + 2048, D, 4096, wb, ldw);
      transpose_matrix<0>(F, W + 8192 + 2048, D, DRIN - 2048, wb + (size_t)4096 * D, ldw);
      transpose_f8_matrix<0, true>(F, W + 8192 + DRIN, D, 8192, w8, I8_W, ldw);
      transpose_f8_matrix<0, true>(F, W, D, 2048, w8 + (size_t)8192 * D, I8_W, ldw);
      transpose_f8_matrix<0, true>(F, W + 6144, D, 2048, w8 + (size_t)10240 * D, I8_W, ldw);
      transpose_f8_matrix<0, true>(F, W + 8192, D, 2048, w8 + (size_t)12288 * D, I8_W, ldw); }
    { bf16* wz = (bf16*)(F.ws + WS_WIN) + (size_t)(4096 + DRIN - 2048) * D; const int total8 = 32 * D / 8; const int gt = blockIdx.x * 512 + F.tid;
      for (int e = gt; e < total8; e += F.G * 512) *(u32x4*)(wz + (size_t)e * 8) = (u32x4){0u, 0u, 0u, 0u}; }
    transpose_matrix<0>(F, F.in[I_HGPROJ], DH, D, (bf16*)(F.ws + WS_HGP));
    transpose_matrix<0>(F, F.in[I_RWPROJ], DH, D, (bf16*)(F.ws + WS_RWP));
    transpose_f8_matrix<0, true>(F, F.in[I_WOUT], D, D, F.ws + WS_WOUT, I8_WOUT);
    lora_weight(F, F.in[I_W2], 128, 256, (bf16*)(F.ws + WS_LW2));
    lora_weight(F, F.in[I_A2], 128, 256, (bf16*)(F.ws + WS_LA2));
    lora_weight(F, F.in[I_G2], 480, 512, (bf16*)(F.ws + WS_LG2));
}
template <bool WRITE_BF, bool WRITE_F32, bool WRITE_F8 = false>
__device__ __forceinline__ void ln_phase(Frame& F, const bf16* T, const float* g, const float* b, unsigned char* x8 = nullptr) {
    float* Y = F.out; bf16* xb = (bf16*)(F.ws + WS_XB);
    int lane_ = threadIdx.x & 63; asm volatile("" : "+v"(lane_));
    for (int row = F.gw; row < MR; row += F.NGW) {
        const u32x4* tr = (const u32x4*)(T + (size_t)row * D) + lane_;
        float v[64]; float s = 0.f;
#pragma unroll
        for (int j = 0; j < 8; ++j) { const u32x4 w = tr[64 * j];
#pragma unroll
            for (int q = 0; q < 4; ++q) { v[8 * j + 2 * q] = __uint_as_float(w[q] << 16); v[8 * j + 2 * q + 1] = __uint_as_float(w[q] & 0xffff0000u); s += v[8 * j + 2 * q] + v[8 * j + 2 * q + 1]; } }
        const float mean = wave_sum(s) * (1.f / D); float s2 = 0.f;
#pragma unroll
        for (int i = 0; i < 64; ++i) { v[i] -= mean; s2 += v[i] * v[i]; }
        const float rstd = 1.f / sqrtf(wave_sum(s2) * (1.f / D) + 1e-5f);
#pragma unroll
        for (int j = 0; j < 8; ++j) { const int c0 = 8 * (lane_ + 64 * j);
            const f32x4 g0 = *(const f32x4*)(g + c0), g1 = *(const f32x4*)(g + c0 + 4), b0 = *(const f32x4*)(b + c0), b1 = *(const f32x4*)(b + c0 + 4);
            const f32x4 y0 = (f32x4){v[8 * j], v[8 * j + 1], v[8 * j + 2], v[8 * j + 3]} * rstd * g0 + b0, y1 = (f32x4){v[8 * j + 4], v[8 * j + 5], v[8 * j + 6], v[8 * j + 7]} * rstd * g1 + b1;
            if (WRITE_F32) { *(f32x4*)(Y + (size_t)row * D + c0) = y0; *(f32x4*)(Y + (size_t)row * D + c0 + 4) = y1; }
            if (WRITE_BF) *(u32x4*)(xb + (size_t)row * D + c0) = (u32x4){pk2(y0[0], y0[1]), pk2(y0[2], y0[3]), pk2(y1[0], y1[1]), pk2(y1[2], y1[3])};
            if (WRITE_F8) *(u32x2*)(x8 + (size_t)row * D + c0) = (u32x2){pk4_i8(y0[0], y0[1], y0[2], y0[3], I8_ACT), pk4_i8(y1[0], y1[1], y1[2], y1[3], I8_ACT)}; }
    }
}

#define MFMA32(a, b, c) __builtin_amdgcn_mfma_f32_32x32x16_bf16((a), (b), (c), 0, 0, 0)
__device__ __forceinline__ void hg_decode(int u, int& h, int& row0, int& nvalid) {
    h = u & 15;
    if (u < 4096) { row0 = (u >> 4) * 64; nvalid = 64; } else { row0 = MPR + ((u - 4096) >> 4) * 16; nvalid = 16; }
}
__device__ __forceinline__ void hg_pass1(Frame& F) {
    LAS unsigned char* L = F.lds;
    LAS bf16* QT = (LAS bf16*)(L); LAS bf16* KT = (LAS bf16*)(L + 17408); LAS bf16* KET = (LAS bf16*)(L + 34816); LAS bf16* VT = (LAS bf16*)(L + 53248); LAS bf16* PP = (LAS bf16*)(L + 71680);
    LAS float* SEG = (LAS float*)(L + 80896);
    const bf16* ZH = (const bf16*)(F.ws + WS_ZH);
    bf16* OI = (bf16*)(F.ws + WS_OI); bf16* UT = (bf16*)(F.ws + WS_UT); bf16* Q0 = (bf16*)(F.ws + WS_Q0); float* ADEC = (float*)(F.ws + WS_ADEC);
    const float* hglb = F.in[I_HGLB];
    const int tid = F.tid, d = tid & 127, seg = tid >> 7, w = F.wave, lane = F.lane, r = lane & 31, hh = lane >> 5;
    bf16 rq[16], rf[16], ri[16];
#define HG1_LOAD(uu) do { int h_, r0_, nv_; hg_decode((uu), h_, r0_, nv_); const bf16* zq_ = ZH + (size_t)r0_ * LDZH + h_ * 128 + d; \
        _Pragma("unroll") for (int i = 0; i < 16; ++i) { const int t_ = seg * 16 + i; const int tc_ = t_ < nv_ ? t_ : 0;        \
            rq[i] = zq_[(size_t)tc_ * LDZH]; rf[i] = zq_[(size_t)tc_ * LDZH + 2048]; ri[i] = zq_[(size_t)tc_ * LDZH + 4096]; } } while (0)
    if ((int)blockIdx.x < HGU) HG1_LOAD((int)blockIdx.x);
    for (int u = blockIdx.x; u < HGU; u += F.G) {
        int h, row0, nvalid; hg_decode(u, h, row0, nvalid);
        const int hd = h * 128 + d;
        const float lb = sigmoidf_(hglb[hd] - hglb[2048 + hd]);
        float q[16], kf[16], Lc[16], vv[16]; float run = 0.f;
#pragma unroll
        for (int i = 0; i < 16; ++i) { const int t = seg * 16 + i; const bool valid = t < nvalid;
            const float qv = valid ? bf2f(rq[i]) : 0.f; float fp = valid ? bf2f(rf[i]) : 0.f; const float iv = valid ? bf2f(ri[i]) : 0.f;
            fp = fminf(fmaxf(fp, -30.f), 30.f);
            const float e = __expf(-fp), sg = __builtin_amdgcn_rcpf(1.f + e), sgn = e * sg;
            const float f = lb + (1.f - lb) * sg;
            const float lf = valid ? __logf(f) : 0.f;
            run += lf; Lc[i] = run; q[i] = qv; kf[i] = valid ? (1.f - lb) * sgn : 0.f; vv[i] = iv; }
        { const int un = u + F.G < HGU ? u + F.G : u; HG1_LOAD(un); }
        SEG[seg * 128 + d] = run;
        __syncthreads();
        const float s0 = SEG[d], s1 = SEG[128 + d], s2 = SEG[256 + d], s3 = SEG[384 + d];
        const float base = (seg > 0 ? s0 : 0.f) + (seg > 1 ? s1 : 0.f) + (seg > 2 ? s2 : 0.f);
        const float Lm = s0 + s1, Lend = Lm + s2 + s3;
        const float eLm = __expf(Lm), eEnd = __expf(Lend - Lm);
        unsigned kep[8], vtp[8];
#pragma unroll
        for (int i = 0; i < 16; i += 2) {
            float ke2[2];
#pragma unroll
            for (int ii = 0; ii < 2; ++ii) { const int t = seg * 16 + i + ii; const float Lt = base + Lc[i + ii];
                const float e1 = __expf(Lt - Lm), e2 = __expf(Lm - Lt);
                const float qt = q[i + ii] * e1, kt = kf[i + ii] * e2;
                QT[t * 136 + d] = (bf16)f2bf(qt); KT[t * 136 + d] = (bf16)f2bf(kt);
                if (t < nvalid) Q0[(size_t)(row0 + t) * DH + hd] = (bf16)f2bf(qt * eLm);
                ke2[ii] = kt * eEnd; }
            kep[i >> 1] = pk2(ke2[0], ke2[1]); vtp[i >> 1] = pk2(vv[i], vv[i + 1]); }
        *(LAS u32x4*)(KET + d * 72 + seg * 16) = (u32x4){kep[0], kep[1], kep[2], kep[3]}; *(LAS u32x4*)(KET + d * 72 + seg * 16 + 8) = (u32x4){kep[4], kep[5], kep[6], kep[7]};
        *(LAS u32x4*)(VT + d * 72 + seg * 16) = (u32x4){vtp[0], vtp[1], vtp[2], vtp[3]}; *(LAS u32x4*)(VT + d * 72 + seg * 16 + 8) = (u32x4){vtp[4], vtp[5], vtp[6], vtp[7]};
        if (seg == 0) ADEC[(size_t)u * 128 + d] = __expf(Lend);
        __syncthreads();
        if (w < 4) { const int ts = w >> 1, tt = w & 1;
            f32x16 acc; for (int i = 0; i < 16; ++i) acc[i] = 0.f;
            if (!(ts == 1 && tt == 0)) {
#pragma unroll
                for (int ks = 0; ks < 8; ++ks) { const bf16x8 a = *(const LAS bf16x8*)(KT + (32 * ts + r) * 136 + 16 * ks + 8 * hh), b = *(const LAS bf16x8*)(QT + (32 * tt + r) * 136 + 16 * ks + 8 * hh);
                    acc = MFMA32(a, b, acc); } }
            const int t = 32 * tt + r;
#pragma unroll
            for (int g = 0; g < 4; ++g) { const int sb = 32 * ts + 8 * g + 4 * hh; float p[4];
#pragma unroll
                for (int j = 0; j < 4; ++j) p[j] = (sb + j <= t) ? acc[4 * g + j] : 0.f;
                *(LAS u32x2*)(PP + t * 72 + sb) = (u32x2){pk2(p[0], p[1]), pk2(p[2], p[3])}; } }
        __syncthreads();
        { const int tv = w >> 1, tt = w & 1; f32x16 acc; for (int i = 0; i < 16; ++i) acc[i] = 0.f;
#pragma unroll
          for (int ks = 0; ks < 4; ++ks) { const bf16x8 a = *(const LAS bf16x8*)(VT + (32 * tv + r) * 72 + 16 * ks + 8 * hh), b = *(const LAS bf16x8*)(PP + (32 * tt + r) * 72 + 16 * ks + 8 * hh);
              acc = MFMA32(a, b, acc); }
          const int t = 32 * tt + r;
          if (t < nvalid) { bf16* op = OI + (size_t)(row0 + t) * DH + h * 128 + 32 * tv + 4 * hh;
#pragma unroll
              for (int g = 0; g < 4; ++g) *(u32x2*)(op + 8 * g) = (u32x2){pk2(acc[4 * g], acc[4 * g + 1]), pk2(acc[4 * g + 2], acc[4 * g + 3])}; } }
#pragma unroll
        for (int x = 0; x < 2; ++x) { const int td = w >> 1, tv = 2 * (w & 1) + x; f32x16 acc; for (int i = 0; i < 16; ++i) acc[i] = 0.f;
#pragma unroll
            for (int ks = 0; ks < 4; ++ks) { const bf16x8 a = *(const LAS bf16x8*)(KET + (32 * td + r) * 72 + 16 * ks + 8 * hh), b = *(const LAS bf16x8*)(VT + (32 * tv + r) * 72 + 16 * ks + 8 * hh);
                acc = MFMA32(a, b, acc); }
            bf16* up = UT + ((size_t)u * 128 + 32 * tv + r) * 128 + 32 * td + 4 * hh;
#pragma unroll
            for (int g = 0; g < 4; ++g) *(u32x2*)(up + 8 * g) = (u32x2){pk2(acc[4 * g], acc[4 * g + 1]), pk2(acc[4 * g + 2], acc[4 * g + 3])}; }
        __syncthreads();
    }
#undef HG1_LOAD
}
__device__ __forceinline__ void hg_pass2(Frame& F) {
    const bf16* UT = (const bf16*)(F.ws + WS_UT); const float* ADEC = (const float*)(F.ws + WS_ADEC); bf16* ST = (bf16*)(F.ws + WS_ST);
#define UT2(p) ({ const unsigned w_ = *(const unsigned*)(p); (f32x2){__uint_as_float(w_ << 16), __uint_as_float(w_ & 0xffff0000u)}; })
    const int gt = blockIdx.x * 512 + F.tid, NT = F.G * 512;
    LAS float* AD = (LAS float*)F.lds;
    const size_t cst = (size_t)16 * 128 * 128;
    for (int e0 = blockIdx.x * 512; e0 < 16 * 128 * 64; e0 += NT) { const int e = e0 + F.tid, dp = e & 63, v = (e >> 6) & 127, h = e0 >> 13, d = 2 * dp;
        const bf16* up = UT + ((size_t)h * 128 + v) * 128 + d; bf16* sp = ST + ((size_t)h * 128 + v) * 128 + d;
        unsigned ring[16];
#pragma unroll
        for (int q = 0; q < 16; ++q) ring[q] = *(const unsigned*)(up + (size_t)q * cst);
        for (int i = F.tid; i < 256 * 32; i += 512) { const int c = i >> 5, d4 = (i & 31) * 4; *(LAS f32x4*)(AD + c * 128 + d4) = *(const f32x4*)(ADEC + ((size_t)c * 16 + h) * 128 + d4); }
        __syncthreads();
        f32x2 S = (f32x2){0.f, 0.f};
        for (int c0 = 0; c0 < 240; c0 += 16) {
#pragma unroll
            for (int q = 0; q < 16; ++q) { const int c = c0 + q; const unsigned w_ = ring[q];
                ring[q] = *(const unsigned*)(up + (size_t)(c + 16) * cst);
                const f32x2 a = *(const LAS f32x2*)(AD + c * 128 + d);
                *(unsigned*)(sp + (size_t)c * cst) = pk2(S[0], S[1]);
                S = a * S + (f32x2){__uint_as_float(w_ << 16), __uint_as_float(w_ & 0xffff0000u)}; } }
#pragma unroll
        for (int q = 0; q < 16; ++q) { const int c = 240 + q; const unsigned w_ = ring[q];
            const f32x2 a = *(const LAS f32x2*)(AD + c * 128 + d);
            *(unsigned*)(sp + (size_t)c * cst) = pk2(S[0], S[1]);
            S = a * S + (f32x2){__uint_as_float(w_ << 16), __uint_as_float(w_ & 0xffff0000u)}; }
        float* o = F.out + O_HGP + ((size_t)h * 128 + d) * 128 + v; o[0] = S[0]; o[128] = S[1];
        __syncthreads(); }
    const float* S0 = F.in[I_SHG];
    for (int e = gt; e < 8 * 16 * 128 * 64; e += NT) { const int dp = e & 63, v = (e >> 6) & 127, sh = e >> 13, d = 2 * dp;
        const size_t u = 4096 + sh; const size_t so = ((size_t)sh * 128 + d) * 128 + v;
        const f32x2 S = (f32x2){S0[so], S0[so + 128]};
        const f32x2 a = *(const f32x2*)(ADEC + u * 128 + d), ut = UT2(UT + (u * 128 + v) * 128 + d);
        *(unsigned*)(ST + (u * 128 + v) * 128 + d) = pk2(S[0], S[1]);
        const f32x2 Sn = a * S + ut;
        float* o = F.out + O_HGS + so; o[0] = Sn[0]; o[128] = Sn[1]; }
}
__device__ __forceinline__ void hg_pass3(Frame& F) {
    LAS unsigned char* L = F.lds;
    LAS bf16* STl = (LAS bf16*)L; LAS bf16* Q0l = (LAS bf16*)(L + 34816); LAS float* SS = (LAS float*)(L + 52224);
    const bf16* ST = (const bf16*)(F.ws + WS_ST); const bf16* Q0 = (const bf16*)(F.ws + WS_Q0); const bf16* OI = (const bf16*)(F.ws + WS_OI);
    const bf16* ZH = (const bf16*)(F.ws + WS_ZH); bf16* OA = (bf16*)(F.ws + WS_OA); const float* ng = F.in[I_HGNG];
    const int tid = F.tid, w = F.wave, lane = F.lane, r = lane & 31, hh = lane >> 5;
    for (int u = blockIdx.x; u < HGU; u += F.G) {
        int h, row0, nvalid; hg_decode(u, h, row0, nvalid);
#pragma unroll
        for (int i = 0; i < 4; ++i) { const int c = tid + 512 * i, v = c >> 4, d8 = (c & 15) * 8;
            *(LAS u32x4*)(STl + v * 136 + d8) = *(const u32x4*)(ST + ((size_t)u * 128 + v) * 128 + d8); }
#pragma unroll
        for (int i = 0; i < 2; ++i) { const int c = tid + 512 * i, t = c >> 4, d8 = (c & 15) * 8;
            u32x4 x = (u32x4){0u, 0u, 0u, 0u}; if (t < nvalid) x = *(const u32x4*)(Q0 + (size_t)(row0 + t) * DH + h * 128 + d8);
            *(LAS u32x4*)(Q0l + t * 136 + d8) = x; }
        const int tv = w >> 1, tt = w & 1, t = 32 * tt + r; const bool tvalid = t < nvalid;
        const size_t rowg = (size_t)(row0 + (tvalid ? t : 0));
        const int vb = h * 128 + 32 * tv + 4 * hh;
        f32x4 oi[4]; u32x2 gwv[4];
#pragma unroll
        for (int g = 0; g < 4; ++g) { const u32x2 ow = *(const u32x2*)(OI + rowg * DH + vb + 8 * g); oi[g] = (f32x4){__uint_as_float(ow.x << 16), __uint_as_float(ow.x & 0xffff0000u), __uint_as_float(ow.y << 16), __uint_as_float(ow.y & 0xffff0000u)};
            gwv[g] = *(const u32x2*)(ZH + rowg * LDZH + 6144 + vb + 8 * g); }
        __syncthreads();
        f32x16 acc; for (int i = 0; i < 16; ++i) acc[i] = 0.f;
#pragma unroll
        for (int ks = 0; ks < 8; ++ks) { const bf16x8 a = *(const LAS bf16x8*)(STl + (32 * tv + r) * 136 + 16 * ks + 8 * hh), b = *(const LAS bf16x8*)(Q0l + (32 * tt + r) * 136 + 16 * ks + 8 * hh);
            acc = MFMA32(a, b, acc); }
        float ss = 0.f;
#pragma unroll
        for (int g = 0; g < 4; ++g) {
#pragma unroll
            for (int j = 0; j < 4; ++j) { acc[4 * g + j] += oi[g][j]; ss += acc[4 * g + j] * acc[4 * g + j]; } }
        ss += __shfl_xor(ss, 32);
        if (hh == 0) SS[t * 4 + tv] = ss;
        __syncthreads();
        const float tot = (SS[t * 4] + SS[t * 4 + 1]) + (SS[t * 4 + 2] + SS[t * 4 + 3]);
        const float rs = 1.f / sqrtf(tot * (1.f / 128.f) + 1e-6f);
        if (tvalid) {
#pragma unroll
            for (int g = 0; g < 4; ++g) { const int col = vb + 8 * g;
                const f32x4 gn = *(const f32x4*)(ng + col); const u32x2 gw = gwv[g];
                const float g0 = __uint_as_float(gw.x << 16), g1 = __uint_as_float(gw.x & 0xffff0000u), g2 = __uint_as_float(gw.y << 16), g3 = __uint_as_float(gw.y & 0xffff0000u);
                const float o0 = acc[4 * g] * rs * gn[0] * (g0 * sigmoidf_(g0)), o1 = acc[4 * g + 1] * rs * gn[1] * (g1 * sigmoidf_(g1));
                const float o2 = acc[4 * g + 2] * rs * gn[2] * (g2 * sigmoidf_(g2)), o3 = acc[4 * g + 3] * rs * gn[3] * (g3 * sigmoidf_(g3));
                *(u32x2*)(OA + rowg * DH + col) = (u32x2){pk2(o0, o1), pk2(o2, o3)}; } }
        __syncthreads();
    }
}

__device__ __forceinline__ float dpp_xor1(float x) { return __builtin_bit_cast(float, __builtin_amdgcn_update_dpp(0, __builtin_bit_cast(int, x), 0xB1, 0xF, 0xF, true)); }
__device__ __forceinline__ float dpp_xor2(float x) { return __builtin_bit_cast(float, __builtin_amdgcn_update_dpp(0, __builtin_bit_cast(int, x), 0x4E, 0xF, 0xF, true)); }
__device__ __forceinline__ float dpp_hmir(float x) { return __builtin_bit_cast(float, __builtin_amdgcn_update_dpp(0, __builtin_bit_cast(int, x), 0x141, 0xF, 0xF, true)); }
__device__ __forceinline__ float dpp_mir(float x)  { return __builtin_bit_cast(float, __builtin_amdgcn_update_dpp(0, __builtin_bit_cast(int, x), 0x140, 0xF, 0xF, true)); }
__device__ __forceinline__ float red16(float x) { x += dpp_xor1(x); x += dpp_xor2(x); x += dpp_hmir(x); x += dpp_mir(x); return x; }
__device__ __forceinline__ float wsum(float x) {
    x = red16(x); const int xi = __builtin_bit_cast(int, x);
    const float r0 = __builtin_bit_cast(float, __builtin_amdgcn_readlane(xi, 0)), r1 = __builtin_bit_cast(float, __builtin_amdgcn_readlane(xi, 16));
    const float r2 = __builtin_bit_cast(float, __builtin_amdgcn_readlane(xi, 32)), r3 = __builtin_bit_cast(float, __builtin_amdgcn_readlane(xi, 48));
    return (r0 + r1) + (r2 + r3);
}
__device__ __forceinline__ float zr_prev(const bf16* ZR, const float* sh0, int row, int col) {
    if (row < MPR) return row == 0 ? 0.f : bf2f(ZR[(size_t)(row - 1) * LDZR + col]);
    const int q = row - MPR, s = q >> 4, t = q & 15;
    return t == 0 ? sh0[(size_t)s * DRIN + col] : bf2f(ZR[(size_t)(row - 1) * LDZR + col]);
}
__device__ __forceinline__ void rw_lora_in(Frame& F) {
    const bf16* ZR = (const bf16*)(F.ws + WS_ZR); bf16* AL = (bf16*)(F.ws + WS_AL); const float* mu = F.in[I_MU]; const float* sh0 = F.in[I_SSH];
    for (int row = F.gw; row < MP; row += F.NGW) {
        float o[16];
#pragma unroll
        for (int it = 0; it < 16; ++it) { const int c = F.lane + 64 * it;
            int src = -1, mode = 0;
            if (it < 2) { src = 6144 + c; mode = 0; } else if (it >= 4 && it < 6) { src = 6272 + (c - 256); mode = 1; } else if (it >= 8) { src = 6400 + (c - 512); mode = 2; if (c >= 992) src = -1; }
            o[it] = 0.f;
            if (src >= 0 && row < MR) { const float cur = bf2f(ZR[(size_t)row * LDZR + src]), prev = zr_prev(ZR, sh0, row, src); const float zs = cur + (prev - cur) * mu[src];
                o[it] = mode == 0 ? tanhf(zs) : (mode == 1 ? zs : sigmoidf_(zs)); } }
#pragma unroll
        for (int it = 0; it < 16; ++it) AL[(size_t)row * 1024 + F.lane + 64 * it] = (bf16)f2bf(o[it]);
    }
    for (int q = F.gw; q < 9; q += F.NGW) { const int row = q == 0 ? MPR - 1 : MPR + 16 * (q - 1) + 15; float* o = q == 0 ? F.out + O_SHP : F.out + O_SHS + (size_t)(q - 1) * DRIN;
        for (int c = F.lane; c < DRIN; c += 64) o[c] = bf2f(ZR[(size_t)row * LDZR + c]); }
}
__device__ __forceinline__ void rw_unit_decode(int u, int& h, int& row0, int& n, int& rec0) {
    if (u < 8192) { h = u >> 8; const int c = u & 255; row0 = 64 * c; n = 64; rec0 = h * MPR + row0; }
    else { const int q = u - 8192, s = q >> 5; h = q & 31; row0 = MPR + 16 * s; n = 16; rec0 = 32 * MPR + q * 16; }
}
__device__ __forceinline__ void rw_prep(Frame& F) {
    const bf16* ZR = (const bf16*)(F.ws + WS_ZR); const bf16* LOGW = (const bf16*)(F.ws + WS_LOGW); const bf16* ASIG = (const bf16*)(F.ws + WS_ASIG);
    float* REC = (float*)(F.ws + WS_REC); float* RK = (float*)(F.ws + WS_RK); float* WC = (float*)(F.ws + WS_WC); float* VS = (float*)(F.ws + WS_VS);
    const float* mu = F.in[I_MU]; const float* sh0 = F.in[I_SSH];
    const int lane = F.lane;
    for (int u = F.gw; u < RWU; u += F.NGW) {
        int h, row0, n, rec0; rw_unit_decode(u, h, row0, n, rec0);
        const int col = h * 64 + lane;
        const float mur = mu[col], muk = mu[2048 + col], muv = mu[4096 + col], kkw = F.in[I_KK][col], kaw = F.in[I_KA][col], rkw = F.in[I_RK][col];
        float pr = zr_prev(ZR, sh0, row0, col), pk = zr_prev(ZR, sh0, row0, 2048 + col), pv = zr_prev(ZR, sh0, row0, 4096 + col);
        float Lw = 0.f;
        bf16 cr[8], ck[8], cv[8], lw[8], as[8], nr[8], nk[8], nv[8], nl[8], na[8];
        const bf16* zp = ZR + (size_t)row0 * LDZR + col; const bf16* lp = LOGW + (size_t)row0 * DH + col; const bf16* ap = ASIG + (size_t)row0 * DH + col;
#define PREP_LD(R_, K_, V_, L_, A_, t) do { _Pragma("unroll") for (int q = 0; q < 8; ++q) { const size_t o_ = (size_t)((t) + q); R_[q] = zp[o_ * LDZR]; K_[q] = zp[o_ * LDZR + 2048]; V_[q] = zp[o_ * LDZR + 4096]; L_[q] = lp[o_ * DH]; A_[q] = ap[o_ * DH]; } } while (0)
        PREP_LD(cr, ck, cv, lw, as, 0);
        for (int t0 = 0; t0 < n; t0 += 8) {
            { const int tn = t0 + 8 < n ? t0 + 8 : t0; PREP_LD(nr, nk, nv, nl, na, tn); }
#pragma unroll
            for (int q = 0; q < 8; ++q) { const int row = row0 + t0 + q;
                const float crq = bf2f(cr[q]), ckq = bf2f(ck[q]), cvq = bf2f(cv[q]);
                const float rr = crq + (pr - crq) * mur, kv = ckq + (pk - ckq) * muk;
                const float nx = -bf2f(lw[q]); const float sp = fmaxf(nx, 0.f) + __logf(1.0f + __expf(-fabsf(nx))); const float lgw = -__expf(-sp - 0.5f); const float asg = sigmoidf_(bf2f(as[q]));
                float kk = kv * kkw; const float nrm = sqrtf(wsum(kk * kk)); kk = kk / fmaxf(nrm, 1e-12f);
                const float k_ = kv * (1.f + (asg - 1.f) * kaw);
                const float rk = wsum(rr * k_ * rkw);
                const float eex = __expf(Lw); Lw += lgw; const float ein = __expf(Lw), einv = __expf(-Lw);
                float* rec = REC + (size_t)(rec0 + t0 + q) * 256;
                rec[lane] = -kk * eex; rec[64 + lane] = kk * asg * einv; rec[128 + lane] = k_ * einv; rec[192 + lane] = rr * ein;
                if (lane == 0) RK[(size_t)row * 32 + h] = rk;
                VS[(size_t)row * DH + col] = cvq + (pv - cvq) * muv;
                pr = crq; pk = ckq; pv = cvq; }
#pragma unroll
            for (int q = 0; q < 8; ++q) { cr[q] = nr[q]; ck[q] = nk[q]; cv[q] = nv[q]; lw[q] = nl[q]; as[q] = na[q]; }
        }
#undef PREP_LD
        WC[(size_t)u * 64 + lane] = __expf(Lw);
    }
}
#define SCAN_BAR() do { asm volatile("s_waitcnt lgkmcnt(0)" ::: "memory"); __builtin_amdgcn_s_barrier(); asm volatile("" ::: "memory"); } while (0)
#define SCAN_BAR() do { asm volatile("s_waitcnt lgkmcnt(0)" ::: "memory"); __builtin_amdgcn_s_barrier(); asm volatile("" ::: "memory"); } while (0)
constexpr int TB = 4, NBUF = 4;
struct ScanState { f32x4 A[4], B[4]; };
__device__ __forceinline__ float ksum(float p) { const f32x4 z = (f32x4){0.f, 0.f, 0.f, 0.f}; const f32x4 d = __builtin_amdgcn_mfma_f32_16x16x4f32(1.0f, p, z, 0, 0, 0); return d[0]; }
__device__ __forceinline__ float dot16(const f32x4 (&S)[4], const f32x4 (&a)[4]) {
    f32x2 p0 = (f32x2){S[0][0], S[0][1]} * (f32x2){a[0][0], a[0][1]}, p1 = (f32x2){S[0][2], S[0][3]} * (f32x2){a[0][2], a[0][3]};
#pragma unroll
    for (int q = 1; q < 4; ++q) { p0 = __builtin_elementwise_fma((f32x2){S[q][0], S[q][1]}, (f32x2){a[q][0], a[q][1]}, p0); p1 = __builtin_elementwise_fma((f32x2){S[q][2], S[q][3]}, (f32x2){a[q][2], a[q][3]}, p1); }
    const f32x2 t = p0 + p1; return t[0] + t[1];
}
template <bool useB>
__device__ __forceinline__ void rw_block4(ScanState& st, const LAS unsigned char* pb, const LAS float* pv, float* outA, float* outB, int kg) {
    f32x4 oa[4], ob[4], ok[4], orr[2][4]; float ov;
#define RW_LD4(dst, P) do { _Pragma("unroll") for (int e = 0; e < 4; ++e) dst[e] = *(const LAS f32x4*)((P) + e * 16); } while (0)
    RW_LD4(oa, pb); RW_LD4(ob, pb + 256); RW_LD4(ok, pb + 512); RW_LD4(orr[0], pb + 768); ov = *pv;
    float ykA = 0.f, ykB = 0.f;
    const f32x4 z = (f32x4){0.f, 0.f, 0.f, 0.f};
#pragma unroll
    for (int ss = 0; ss < 4; ++ss) {
        const bool more = ss < 3;
        const LAS unsigned char* pn = pb + (ss + 1) * 1024; const LAS float* vn = pv + (ss + 1) * 16;
        const float pa = dot16(st.A, oa), pq = useB ? dot16(st.B, oa) : 0.f;
        const f32x4 da = __builtin_amdgcn_mfma_f32_16x16x4f32(1.0f, pa, z, 0, 0, 0);
        f32x4 db = z; if (useB) db = __builtin_amdgcn_mfma_f32_16x16x4f32(1.0f, pq, z, 0, 0, 0);
        if (more) RW_LD4(oa, pn);
        if (ss > 0) { const float y = ksum(dot16(st.A, orr[(ss + 1) & 1])); ykA = (kg == ss - 1) ? y : ykA;
            if (useB) { const float c = ksum(dot16(st.B, orr[(ss + 1) & 1])); ykB = (kg == ss - 1) ? c : ykB; } }
        if (more) RW_LD4(orr[(ss + 1) & 1], pn + 768);
        const float sa = da[0], sb = db[0];
        const f32x4 sa4 = (f32x4){sa, sa, sa, sa}, sb4 = (f32x4){sb, sb, sb, sb}, v4 = (f32x4){ov, ov, ov, ov};
#pragma unroll
        for (int e = 0; e < 4; ++e) { st.A[e] = __builtin_elementwise_fma(ob[e], sa4, st.A[e]); st.A[e] = __builtin_elementwise_fma(ok[e], v4, st.A[e]); if (useB) st.B[e] = __builtin_elementwise_fma(ob[e], sb4, st.B[e]); }
        if (more) { RW_LD4(ob, pn + 256); RW_LD4(ok, pn + 512); ov = *vn; }
    }
    { const float y = ksum(dot16(st.A, orr[1])); ykA = (kg == 3) ? y : ykA; outA[(size_t)kg * DH] = ykA;
      if (useB) { const float c = ksum(dot16(st.B, orr[1])); ykB = (kg == 3) ? c : ykB; outB[(size_t)kg * DH] = ykB; } }
#undef RW_LD4
}
__device__ __forceinline__ void rw_issue(Frame& F, int w, int k, int rec, const float* vrow0, const float* wcp, int par, int lane) {
    const float* REC = (const float*)(F.ws + WS_REC);
    LAS unsigned char* dst = F.lds + w * 16384 + k * 4096;
    const unsigned* gp = (const unsigned*)(REC + (size_t)rec * 256 + lane * 4); LAS unsigned* lp = (LAS unsigned*)dst;
    __builtin_amdgcn_global_load_lds(gp, lp, 16, 0, 0); __builtin_amdgcn_global_load_lds(gp, lp, 16, 1024, 0); __builtin_amdgcn_global_load_lds(gp, lp, 16, 2048, 0); __builtin_amdgcn_global_load_lds(gp, lp, 16, 3072, 0);
    __builtin_amdgcn_global_load_lds((const unsigned*)(vrow0 + (size_t)(lane >> 4) * DH + (lane & 15)), (LAS unsigned*)(F.lds + 131072 + w * 1024 + k * 256), 4, 0, 0);
    __builtin_amdgcn_global_load_lds((const unsigned*)(wcp + lane), (LAS unsigned*)(F.lds + 139264 + w * 512 + par * 256), 4, 0, 0);
}
template <bool useB>
__device__ __forceinline__ void rw_job(Frame& F, ScanState& st, int rec0, const float* vrow0, const float* wcp0, int nsteps, float* outA0, float* outB0, int w, int lane) {
    const int r = lane & 15, kg = lane >> 4; const int nb = nsteps / TB;
#define RW_ISS(bb) rw_issue(F, w, (bb) & 3, rec0 + (bb) * TB, vrow0 + (size_t)((bb) * TB) * DH, wcp0 + ((bb) >> 4) * 64, ((bb) >> 4) & 1, lane)
    RW_ISS(0); if (nb > 1) RW_ISS(1); if (nb > 2) RW_ISS(2);
    for (int b = 0; b < nb; ++b) {
        if (b + 3 < nb) { RW_ISS(b + 3); asm volatile("s_waitcnt vmcnt(18)" ::: "memory"); }
        else asm volatile("s_waitcnt vmcnt(0)" ::: "memory");
        const LAS unsigned char* pb = F.lds + w * 16384 + (b & 3) * 4096 + kg * 64; const LAS float* pv = (const LAS float*)(F.lds + 131072 + w * 1024 + (b & 3) * 256) + r;
        rw_block4<useB>(st, pb, pv, outA0 + (size_t)(b * TB) * DH, useB ? outB0 + (size_t)(b * TB) * DH : nullptr, kg);
        if ((b & 15) == 15 || b == nb - 1) {
#pragma unroll
            for (int e = 0; e < 4; ++e) { const f32x4 wc = *(const LAS f32x4*)(F.lds + 139264 + w * 512 + ((b >> 4) & 1) * 256 + kg * 64 + e * 16); st.A[e] = st.A[e] * wc; if (useB) st.B[e] = st.B[e] * wc; } }
        asm volatile("s_waitcnt lgkmcnt(0)" ::: "memory");
    }
#undef RW_ISS
}
__device__ __forceinline__ void rw_scan_prompt(Frame& F, int h, int sl, int half) {
    const float* WC = (const float*)(F.ws + WS_WC); const float* VS = (const float*)(F.ws + WS_VS);
    float* Y = (float*)(F.ws + WS_Y); float* C = (float*)(F.ws + WS_C); float* SZ = (float*)(F.ws + WS_SZ); float* SQ = (float*)(F.ws + WS_SQ);
    const int w = F.wave, lane = F.lane, r = lane & 15, kg = lane >> 4;
    const int seg = 8 * half + w; const bool useB = seg > 0;
    const int row = 16 * sl + r;
    ScanState st;
#pragma unroll
    for (int e = 0; e < 4; ++e) { st.A[e] = (f32x4){0.f, 0.f, 0.f, 0.f};
#pragma unroll
        for (int c = 0; c < 4; ++c) st.B[e][c] = (16 * kg + 4 * e + c == row) ? 1.f : 0.f; }
    const int t0 = seg * SEGLEN;
    if (useB) rw_job<true>(F, st, h * MPR + t0, VS + (size_t)t0 * DH + h * 64 + 16 * sl, WC + (size_t)(h * 256 + (t0 >> 6)) * 64, SEGLEN, Y + (size_t)t0 * DH + h * 64 + row, C + (size_t)(t0 - SEGLEN) * DH + h * 64 + row, w, lane);
    else rw_job<false>(F, st, h * MPR + t0, VS + (size_t)t0 * DH + h * 64 + 16 * sl, WC + (size_t)(h * 256 + (t0 >> 6)) * 64, SEGLEN, Y + (size_t)t0 * DH + h * 64 + row, nullptr, w, lane);
    { float* so = SZ + ((size_t)(h * NSEG + seg) * 64 + row) * 64 + 16 * kg;
#pragma unroll
      for (int e = 0; e < 4; ++e) *(f32x4*)(so + 4 * e) = st.A[e]; }
    if (useB) { float* so = SQ + ((size_t)(h * NSEG + seg) * 64 + row) * 64 + 16 * kg;
#pragma unroll
        for (int e = 0; e < 4; ++e) *(f32x4*)(so + 4 * e) = st.B[e]; }
}
__device__ __forceinline__ void rw_scan_sample(Frame& F) {
    const float* WC = (const float*)(F.ws + WS_WC); const float* VS = (const float*)(F.ws + WS_VS); float* Y = (float*)(F.ws + WS_Y);
    const int w = F.wave, lane = F.lane, r = lane & 15, kg = lane >> 4;
    for (int q = F.gw; q < 1024; q += F.NGW) { const int sl = q & 3, sh = q >> 2, hh = sh & 31, sq = sh >> 5; const int row = 16 * sl + r;
        const float* S0 = F.in[I_SRW] + (size_t)sh * 4096 + (size_t)row * 64 + 16 * kg;
        ScanState st;
#pragma unroll
        for (int e = 0; e < 4; ++e) { st.A[e] = *(const f32x4*)(S0 + 4 * e); st.B[e] = (f32x4){0.f, 0.f, 0.f, 0.f}; }
        rw_job<false>(F, st, 32 * MPR + sh * 16, VS + (size_t)(MPR + 16 * sq) * DH + hh * 64 + 16 * sl, WC + (size_t)(8192 + sh) * 64, 16, Y + (size_t)(MPR + 16 * sq) * DH + hh * 64 + row, nullptr, w, lane);
        float* so = F.out + O_RWS + (size_t)sh * 4096 + (size_t)row * 64 + 16 * kg;
#pragma unroll
        for (int e = 0; e < 4; ++e) *(f32x4*)(so + 4 * e) = st.A[e];
    }
}
__device__ __forceinline__ void rw_scan(Frame& F) {
    for (int bb = blockIdx.x; bb < 256; bb += F.G) { const int x = bb & 7, i = bb >> 3, h = x * 4 + (i >> 3), j = i & 7; rw_scan_prompt(F, h, j >> 1, j & 1); }
    rw_scan_sample(F);
}
__device__ __forceinline__ void rw_compose(Frame& F) {
    const float* SZ = (const float*)(F.ws + WS_SZ); const float* SQ = (const float*)(F.ws + WS_SQ); float* SST = (float*)(F.ws + WS_SST);
    const int lane = F.lane, tid = F.tid;
    LAS float* Qb = (LAS float*)F.lds;
    for (int bb = blockIdx.x; bb < 256; bb += F.G) { const int x = bb & 7, i8 = bb >> 3, h = x * 4 + (i8 >> 3), v = 8 * (i8 & 7) + F.wave;
        const size_t hb = (size_t)(h * NSEG) * 4096;
        f32x4 q0 = *(const f32x4*)(SQ + hb + 4096 + tid * 8), q1 = *(const f32x4*)(SQ + hb + 4096 + tid * 8 + 4);
        float srow = SZ[hb + (size_t)v * 64 + lane];
        float nz = SZ[hb + 4096 + (size_t)v * 64 + lane];
        *(LAS f32x4*)(Qb + tid * 8) = q0; *(LAS f32x4*)(Qb + tid * 8 + 4) = q1;
        __syncthreads();
        for (int k = 1; k < NSEG; ++k) {
            float nzn = 0.f;
            if (k + 1 < NSEG) { const size_t o = hb + (size_t)(k + 1) * 4096; q0 = *(const f32x4*)(SQ + o + tid * 8); q1 = *(const f32x4*)(SQ + o + tid * 8 + 4); nzn = SZ[o + (size_t)v * 64 + lane]; }
            SST[hb + (size_t)k * 4096 + (size_t)v * 64 + lane] = srow;
            const LAS float* q = Qb + ((k - 1) & 1) * 4096 + lane;
            float n0 = nz, n1 = 0.f;
            const int si = __builtin_bit_cast(int, srow);
#pragma unroll
            for (int i = 0; i < 64; i += 2) { n0 = fmaf(__builtin_bit_cast(float, __builtin_amdgcn_readlane(si, i)), q[i * 64], n0); n1 = fmaf(__builtin_bit_cast(float, __builtin_amdgcn_readlane(si, i + 1)), q[(i + 1) * 64], n1); }
            srow = n0 + n1; nz = nzn;
            if (k + 1 < NSEG) { LAS float* qd = Qb + (k & 1) * 4096 + tid * 8; *(LAS f32x4*)qd = q0; *(LAS f32x4*)(qd + 4) = q1; }
            __syncthreads();
        }
        F.out[O_RWP + ((size_t)h * 64 + v) * 64 + lane] = srow;
    }
}
__device__ __forceinline__ void rw_post(Frame& F) {
    const float* Y = (const float*)(F.ws + WS_Y); const float* C = (const float*)(F.ws + WS_C); const float* SST = (const float*)(F.ws + WS_SST); const float* VS = (const float*)(F.ws + WS_VS);
    const float* RK = (const float*)(F.ws + WS_RK); const bf16* G = (const bf16*)(F.ws + WS_G);
    bf16* OB = (bf16*)(F.ws + WS_OB); const float* lng = F.in[I_LNG]; const float* lnb = F.in[I_LNB];
    const int lane = F.lane;
    for (int u = F.gw; u < 32 * (MR / 64); u += F.NGW) { const int h = u & 31, rb0 = (u >> 5) * 64, col = h * 64 + lane;
        const float g_ = lng[col], b_ = lnb[col];
        const int k = rb0 < MPR ? (rb0 / SEGLEN) : 0;
        f32x4 Sr[16];
        if (k > 0) {
#pragma unroll
            for (int q = 0; q < 16; ++q) Sr[q] = *(const f32x4*)(SST + ((size_t)(h * NSEG + k) * 64 + lane) * 64 + 4 * q); }
        const float* yp = Y + (size_t)rb0 * DH + col; const float* vp = VS + (size_t)rb0 * DH + col; const bf16* gp = G + (size_t)rb0 * DH + col; const float* rp = RK + (size_t)rb0 * 32 + h;
        const float* cp = k > 0 ? C + (size_t)(rb0 - SEGLEN) * DH + col : yp;
        float y[8], vv[8], rk[8], cc[8]; bf16 gg[8];
#define POST_LD(Y_, V_, G_, R_, C_, t) do { _Pragma("unroll") for (int q = 0; q < 8; ++q) { const size_t o_ = (size_t)((t) + q) * DH; Y_[q] = yp[o_]; V_[q] = vp[o_]; G_[q] = gp[o_]; R_[q] = rp[((t) + q) * 32]; C_[q] = cp[o_]; } } while (0)
        POST_LD(y, vv, gg, rk, cc, 0);
        for (int t0 = 0; t0 < 64; t0 += 8) {
            float ny[8], nv[8], nr[8], nc[8]; bf16 ng[8];
            const int tn = t0 + 8 < 64 ? t0 + 8 : t0;
            POST_LD(ny, nv, ng, nr, nc, tn);
            if (k > 0) {
                LAS float* cs = (LAS float*)(F.lds + 131072 + F.wave * 1024);
#pragma unroll
                for (int hf = 0; hf < 2; ++hf) {
#pragma unroll
                    for (int q = 0; q < 4; ++q) cs[q * 64 + lane] = cc[4 * hf + q];
                    asm volatile("s_waitcnt lgkmcnt(0)" ::: "memory");
#pragma unroll
                    for (int q = 0; q < 4; ++q) { f32x4 a = (f32x4){0.f, 0.f, 0.f, 0.f};
#pragma unroll
                        for (int i = 0; i < 16; ++i) a = __builtin_elementwise_fma(Sr[i], *(const LAS f32x4*)(cs + q * 64 + 4 * i), a);
                        y[4 * hf + q] += (a[0] + a[1]) + (a[2] + a[3]); }
                    asm volatile("s_waitcnt lgkmcnt(0)" ::: "memory"); }
            }
#pragma unroll
            for (int q = 0; q < 8; ++q) { const int row = rb0 + t0 + q;
                const float mean = wsum(y[q]) * (1.f / 64.f); const float dv = y[q] - mean; const float var = wsum(dv * dv) * (1.f / 64.f);
                const float yn = dv * (1.f / sqrtf(var + 64e-5f)) * g_ + b_;
                OB[(size_t)row * DH + col] = (bf16)f2bf((yn + rk[q] * vv[q]) * bf2f(gg[q])); }
#pragma unroll
            for (int q = 0; q < 8; ++q) { y[q] = ny[q]; vv[q] = nv[q]; gg[q] = ng[q]; rk[q] = nr[q]; cc[q] = nc[q]; }
        }
#undef POST_LD
    }
}

__global__ void __launch_bounds__(512, 2) fwd_kernel(Params P) {
    extern __shared__ __attribute__((aligned(16))) unsigned char lds_raw[];
    Frame F;
    F.lds = (LAS unsigned char*)lds_raw;
    F.tid = threadIdx.x; F.lane = F.tid & 63; F.wave = __builtin_amdgcn_readfirstlane(F.tid >> 6);
    F.G = gridDim.x; F.gw = blockIdx.x * 8 + F.wave; F.NGW = F.G * 8;
    F.in = P.in; F.out = P.out; F.ws = P.ws;
    volatile LAS unsigned* MISC = (volatile LAS unsigned*)(F.lds + MISC_OFF);
    if (F.tid < 32) MISC[F.tid] = 0u;
    __syncthreads();
    XcdBarrier bar = xcd_barrier_post((unsigned*)(P.ws + WS_CTL) + 1024, MISC + 8);
#define GRID_BAR() xcd_barrier(bar)
#ifndef PHASE_MASK
#define PHASE_MASK 0xFFFFFFFFu
#endif
#define PH(k) ((PHASE_MASK >> (k)) & 1u)
    bf16* XB = (bf16*)(P.ws + WS_XB); bf16* HB = (bf16*)(P.ws + WS_H);

    if (PH(0)) p0_prologue(F);
    GRID_BAR();
    if (PH(1)) { pg8::Gemm g{(const bf16*)(P.ws + WS_XB8), (const bf16*)(P.ws + WS_WFI), MP, NFF, D / 2, D / 2, D / 2}; pg8::StaticOrder S; S.init(MP, NFF, F.G, (int)blockIdx.x);
      pg8::EpiSwiGLU<2, true> E{HB}; pg8::gemm_phase(F.lds, g, S, E); }
    GRID_BAR();
    if (PH(2)) { pg8::Gemm g{HB, (const bf16*)(P.ws + WS_WFD), MPR, D, DFF / 2, DFF / 2, DFF / 2}; pg8::StaticOrder S; S.init(MPR, D, F.G, (int)blockIdx.x, 4);
      pg8::EpiResid<true, 1> E{(bf16*)(P.ws + WS_T1), P.in[I_XP], P.in[I_XS], nullptr, 0.5f / pg8::W8SCALE_DN}; pg8::gemm_phase(F.lds, g, S, E);
      SkResidSplit K2{(bf16*)(P.ws + WS_T1), P.in[I_XS], 0.5f / pg8::W8SCALE_DN}; skinny_phase<true>(F.lds, HB, DFF, (const bf16*)(P.ws + WS_WFD), DFF, DFF, K2); }
    GRID_BAR();
    if (PH(3)) ln_phase<true, false, true>(F, (const bf16*)(P.ws + WS_T1), P.in[I_LN1G], P.in[I_LN1B], P.ws + WS_H);
    GRID_BAR();
    if (PH(4)) { { pg8::Gemm g{XB, (const bf16*)(P.ws + WS_WIN), MP, 35 * 256, D, D, D}; pg8::StaticOrder S; S.init(MP, 35 * 256, F.G, (int)blockIdx.x);
        pg8::EpiZr<false> E{(bf16*)(P.ws + WS_ZH), (bf16*)(P.ws + WS_ZR), (bf16*)(P.ws + WS_ZG)}; pg8::gemm_phase(F.lds, g, S, E); }
      { pg8::Gemm g{(const bf16*)(P.ws + WS_H), (const bf16*)(P.ws + WS_WIN8), MP, 56 * 256, D / 2, D / 2, D / 2}; pg8::StaticOrder S; S.init(MP, 56 * 256, F.G, (int)((blockIdx.x + 29) % F.G));
        pg8::EpiZr<true> E{(bf16*)(P.ws + WS_ZH), (bf16*)(P.ws + WS_ZR), (bf16*)(P.ws + WS_ZG)}; pg8::gemm_phase(F.lds, g, S, E); } }
    GRID_BAR();
    if (PH(5)) { hg_pass1(F);
    rw_lora_in(F); }
    GRID_BAR();
    if (PH(6)) hg_pass2(F);
    GRID_BAR();
    if (PH(7)) hg_pass3(F);
    GRID_BAR();
    if (PH(8)) { const bf16* AL = (const bf16*)(P.ws + WS_AL);
      { pg8::Gemm g{AL, (const bf16*)(P.ws + WS_LW2), MP, DH, 256, 1024, 256}; pg8::StaticOrder S; S.init(MP, DH, F.G, (int)((blockIdx.x + F.G - 16) % F.G));
        pg8::EpiLoraF32 E{(bf16*)(P.ws + WS_LOGW), P.in[I_W0]}; pg8::gemm_phase(F.lds, g, S, E); }
      { pg8::Gemm g{AL + 256, (const bf16*)(P.ws + WS_LA2), MP, DH, 256, 1024, 256}; pg8::StaticOrder S; S.init(MP, DH, F.G, (int)((blockIdx.x + F.G - 8) % F.G));
        pg8::EpiLoraF32 E{(bf16*)(P.ws + WS_ASIG), P.in[I_A0]}; pg8::gemm_phase(F.lds, g, S, E); }
      { pg8::Gemm g{AL + 512, (const bf16*)(P.ws + WS_LG2), MP, DH, 512, 1024, 512}; pg8::StaticOrder S; S.init(MP, DH, F.G, (int)((blockIdx.x + F.G - 0) % F.G));
        pg8::EpiBf16Plain E{(bf16*)(P.ws + WS_G), DH}; pg8::gemm_phase(F.lds, g, S, E); } }
    GRID_BAR();
    if (PH(9)) rw_prep(F);
    GRID_BAR();
    if (PH(10)) rw_scan(F);
    GRID_BAR();
    rw_compose(F);
    GRID_BAR();
    if (PH(11)) { rw_post(F);
    transpose_f8_matrix<1, true>(F, P.in[I_F2IN], D, NFF, P.ws + WS_WFI, I8_W);
    transpose_f8_matrix<0>(F, P.in[I_F2DN], DFF, D, P.ws + WS_WFD, pg8::W8SCALE_DN); }
    GRID_BAR();
    if (PH(12)) { pg8::Gemm g{(const bf16*)(P.ws + WS_OA), (const bf16*)(P.ws + WS_HGP), MPR, D, DH, DH, DH}; pg8::StaticOrder S; S.init(MPR, D, F.G, (int)blockIdx.x);
      pg8::EpiProj<true> E{(bf16*)(P.ws + WS_MB), (const bf16*)(P.ws + WS_ZG), 0, nullptr}; pg8::gemm_phase(F.lds, g, S, E);
      SkProj<true> K2{(bf16*)(P.ws + WS_MB), (const bf16*)(P.ws + WS_ZG), 0, nullptr}; skinny_phase(F.lds, (const bf16*)(P.ws + WS_OA), DH, (const bf16*)(P.ws + WS_HGP), DH, DH, K2); }
    GRID_BAR();
    if (PH(13)) { pg8::Gemm g{(const bf16*)(P.ws + WS_OB), (const bf16*)(P.ws + WS_RWP), MPR, D, DH, DH, DH}; pg8::StaticOrder S; S.init(MPR, D, F.G, (int)blockIdx.x);
      pg8::EpiProj<false> E{(bf16*)(P.ws + WS_MB), (const bf16*)(P.ws + WS_ZG), 4096, P.ws + WS_XB8}; pg8::gemm_phase(F.lds, g, S, E);
      SkProj<false> K2{(bf16*)(P.ws + WS_MB), (const bf16*)(P.ws + WS_ZG), 4096, P.ws + WS_XB8}; skinny_phase(F.lds, (const bf16*)(P.ws + WS_OB), DH, (const bf16*)(P.ws + WS_RWP), DH, DH, K2); }
    GRID_BAR();
    if (PH(14)) { pg8::Gemm g{(const bf16*)(P.ws + WS_XB8), (const bf16*)(P.ws + WS_WOUT), MPR, D, D / 2, D / 2, D / 2}; pg8::StaticOrder S; S.init(MPR, D, F.G, (int)blockIdx.x, 4);
      pg8::EpiResid<false, 2> E{(bf16*)(P.ws + WS_T2), nullptr, nullptr, XB, I8_DEQ_OUT}; pg8::gemm_phase(F.lds, g, S, E);
      SkResidBf K2{(bf16*)(P.ws + WS_T2), XB, I8_DEQ_OUT}; skinny_phase<2>(F.lds, (const bf16*)(P.ws + WS_XB8), D, (const bf16*)(P.ws + WS_WOUT), D, D, K2); }
    GRID_BAR();
    if (PH(15)) ln_phase<true, false, true>(F, (const bf16*)(P.ws + WS_T2), P.in[I_LN2G], P.in[I_LN2B], P.ws + WS_XB8);
    GRID_BAR();
    if (PH(16)) { pg8::Gemm g{(const bf16*)(P.ws + WS_XB8), (const bf16*)(P.ws + WS_WFI), MP, NFF, D / 2, D / 2, D / 2}; pg8::StaticOrder S; S.init(MP, NFF, F.G, (int)blockIdx.x);
      pg8::EpiSwiGLU<2, true> E{HB}; pg8::gemm_phase(F.lds, g, S, E); }
    GRID_BAR();
    if (PH(17)) { unsigned char* wsp = P.ws; asm volatile("" : "+s"(wsp));
      bf16* xb17 = (bf16*)(wsp + WS_XB); bf16* hb17 = (bf16*)(wsp + WS_H);
      pg8::Gemm g{hb17, (const bf16*)(wsp + WS_WFD), MPR, D, DFF / 2, DFF / 2, DFF / 2}; pg8::StaticOrder S; S.init(MPR, D, F.G, (int)blockIdx.x, 4);
      pg8::EpiResid<false, 1> E{(bf16*)(wsp + WS_T3), nullptr, nullptr, xb17, 0.5f / pg8::W8SCALE_DN}; pg8::gemm_phase(F.lds, g, S, E);
      SkResidBf K2{(bf16*)(wsp + WS_T3), xb17, 0.5f / pg8::W8SCALE_DN}; skinny_phase<true>(F.lds, hb17, DFF, (const bf16*)(wsp + WS_WFD), DFF, DFF, K2); }
    GRID_BAR();
    if (PH(18)) ln_phase<false, true>(F, (const bf16*)(P.ws + WS_T3), P.in[I_LN3G], P.in[I_LN3B]);
}

extern "C" void kernel_launch(void* const* d_in, const int* in_sizes, int n_in, void* d_out, int out_size, void* d_ws, size_t ws_size, hipStream_t stream) {
    static int grid = 0;
    if (grid == 0) {
        if (n_in != 32 || out_size != (int)O_END || ws_size < WS_END) { fprintf(stderr, "kernel_launch: unexpected sizes n_in %d out %d ws %zu (need %zu)\n", n_in, out_size, ws_size, (size_t)WS_END); grid = -1; return; }
        int dev = 0, cus = 0;
        if (hipGetDevice(&dev) != hipSuccess || hipDeviceGetAttribute(&cus, hipDeviceAttributeMultiprocessorCount, dev) != hipSuccess) { grid = -1; return; }
        if (hipFuncSetAttribute((const void*)fwd_kernel, hipFuncAttributeMaxDynamicSharedMemorySize, LDS_BYTES) != hipSuccess) { fprintf(stderr, "kernel_launch: hipFuncSetAttribute failed\n"); grid = -1; return; }
        int per_cu = 0; (void)hipOccupancyMaxActiveBlocksPerMultiprocessor(&per_cu, (const void*)fwd_kernel, 512, LDS_BYTES); (void)hipGetLastError();
        if (per_cu < 1) fprintf(stderr, "kernel_launch: occupancy query reports %d\n", per_cu);
        grid = cus;
    }
    if (grid < 0) return;
    (void)hipMemsetAsync((char*)d_ws + WS_CTL, 0, CTL_ZERO_BYTES, stream);
    Params p{};
    for (int i = 0; i < 32; ++i) p.in[i] = (const float*)d_in[i];
    p.out = (float*)d_out; p.ws = (unsigned char*)d_ws;
    hipLaunchKernelGGL(fwd_kernel, dim3(grid), dim3(512), LDS_BYTES, stream, p);
}
```

```cpp
#include <hip/hip_runtime.h>
#include <stdio.h>

#define LAS __attribute__((address_space(3)))
#define GAS __attribute__((address_space(1)))
typedef unsigned short bf16;
typedef short bf16x8 __attribute__((ext_vector_type(8)));
typedef float f32x4 __attribute__((ext_vector_type(4)));
typedef float f32x2 __attribute__((ext_vector_type(2)));
typedef float f32x16 __attribute__((ext_vector_type(16)));
typedef unsigned u32x4 __attribute__((ext_vector_type(4)));
typedef unsigned u32x2 __attribute__((ext_vector_type(2)));

constexpr int D = 4096, MPR = 16384, MSM = 128, MR = MPR + MSM, MP = 16640;
constexpr int DFF = 11008, NFF = 2 * DFF;
constexpr int DH = 2048;
constexpr int DRIN = 6880, DRINP = 6912;
constexpr int NZ = 8192 + DRINP + 8192;
constexpr int LDZH = 8192, LDZR = DRINP, LDZG = 8192;
constexpr float ALPHA = 1.18920711500272f;
constexpr int HGU = 4096 + 128;
constexpr int RWU = 32 * 256 + 256;
constexpr int NREC = MR * 32;

constexpr size_t O_Y = 0, O_HGP = 67633152, O_RWP = 67895296, O_SHP = 68026368, O_HGS = 68033248, O_RWS = 70130400, O_SHS = 71178976, O_END = 71234016;

constexpr size_t MiB = 1u << 20;
constexpr size_t WS_CTL = 0, CTL_ZERO_BYTES = 64 * 1024;
constexpr size_t WS_XB = 1 * MiB;
constexpr size_t WS_WFI = 131 * MiB;
constexpr size_t WS_WFD = 303 * MiB;
constexpr size_t WS_H = 389 * MiB;
constexpr size_t WS_WIN = 739 * MiB;
constexpr size_t WS_ZH = 921 * MiB, WS_ZR = 1181 * MiB, WS_ZG = 1401 * MiB;
constexpr size_t WS_HGP = 1661 * MiB, WS_RWP = 1677 * MiB, WS_WOUT = 1693 * MiB, WS_LW2 = 1725 * MiB, WS_LA2 = 1726 * MiB, WS_LG2 = 1727 * MiB;
constexpr size_t WS_AL = 1729 * MiB;
constexpr size_t WS_RK = 1762 * MiB;
constexpr size_t WS_WC = 1765 * MiB;
constexpr size_t WS_ADEC = 1768 * MiB;
constexpr size_t WS_SZ = 1771 * MiB, WS_SQ = 1779 * MiB, WS_SST = 1787 * MiB;
constexpr size_t WS_END = 1795 * MiB;
constexpr size_t WS_WIN8 = 859 * MiB;
constexpr size_t WS_XB8 = 1181 * MiB;
constexpr int NSEG = 16, SEGLEN = MPR / NSEG;
constexpr size_t WS_OI = 131 * MiB;
constexpr size_t WS_UT = 261 * MiB;
constexpr size_t WS_Q0 = 525 * MiB;
constexpr size_t WS_ST = 590 * MiB;
constexpr size_t WS_OA = 856 * MiB;
constexpr size_t WS_REC = 131 * MiB;
constexpr size_t WS_VS = 647 * MiB;
constexpr size_t WS_Y = 921 * MiB;
constexpr size_t WS_C = 1050 * MiB;
constexpr size_t WS_G = 776 * MiB;
constexpr size_t WS_LOGW = 921 * MiB, WS_ASIG = 1051 * MiB;
constexpr size_t WS_OB = 389 * MiB;
constexpr size_t WS_MB = 986 * MiB;
constexpr size_t WS_T1 = 921 * MiB, WS_T2 = 389 * MiB, WS_T3 = 921 * MiB;

constexpr int LDS_BYTES = 147456;
constexpr int MISC_OFF = LDS_BYTES - 256;

__device__ __forceinline__ float bf2f(bf16 x) { return __uint_as_float(((unsigned)x) << 16); }
typedef __bf16 bf16x2_t __attribute__((ext_vector_type(2)));
__device__ __forceinline__ unsigned cvt_pk_bf16(float lo, float hi) { return __builtin_bit_cast(unsigned, __builtin_convertvector((f32x2){lo, hi}, bf16x2_t)); }
__device__ __forceinline__ unsigned pk2(float lo, float hi) { return cvt_pk_bf16(lo, hi); }
__device__ __forceinline__ unsigned pk4_f8(float a, float b, float c, float d) { int w = __builtin_amdgcn_cvt_pk_fp8_f32(a, b, 0, false); w = __builtin_amdgcn_cvt_pk_fp8_f32(c, d, w, true); return (unsigned)w; }
__device__ __forceinline__ unsigned f2bf(float f) { return cvt_pk_bf16(f, 0.f) & 0xffffu; }
__device__ __forceinline__ float sigmoidf_(float x) { return __builtin_amdgcn_rcpf(1.0f + __expf(-x)); }

__device__ __forceinline__ unsigned pk4_i8(float a, float b, float c, float d, float s) {
    const unsigned ua = __float_as_uint(__builtin_amdgcn_fmed3f(a * s, -127.f, 127.f) + 12582912.f), ub = __float_as_uint(__builtin_amdgcn_fmed3f(b * s, -127.f, 127.f) + 12582912.f);
    const unsigned uc = __float_as_uint(__builtin_amdgcn_fmed3f(c * s, -127.f, 127.f) + 12582912.f), ud = __float_as_uint(__builtin_amdgcn_fmed3f(d * s, -127.f, 127.f) + 12582912.f);
    return (ua & 0xffu) | ((ub & 0xffu) << 8) | ((uc & 0xffu) << 16) | (ud << 24);
}
constexpr float I8_MB = 127.f / 2.6f, I8_WOUT = 127.f / (4.f * 0.59460356f / 64.f), I8_DEQ_OUT = 1.f / (I8_MB * I8_WOUT);
constexpr float I8_CLIP = 4.f, I8_ACT = 127.f / I8_CLIP, I8_W = 127.f * 64.f / I8_CLIP, I8_DEQ = 1.f / (I8_ACT * I8_W);
namespace pg8 {
constexpr float W8SCALE_DN = 128.f;
constexpr float W8SCALE = 64.f;
constexpr int BM = 256, BK = 64, HALF = 128, HTB = HALF * BK * 2, STAGE_BYTES = 8 * HTB, NXCD = 8, WGM = 8;
__host__ __device__ __forceinline__ int lds_byte(int r, int c) { const int st = (r >> 4) * 2 + (c >> 5), rr = r & 15, cc = c & 31, ob = rr * 64 + cc * 2; return st * 1024 + (ob ^ (((ob >> 9) & 1) << 5)); }
__host__ __device__ __forceinline__ void stage_rc(int b, int& R, int& C) { const int st = b / 1024, sb = b % 1024, swz = sb ^ (((sb >> 9) & 1) << 5); R = (st >> 1) * 16 + swz / 64; C = (st & 1) * 32 + (swz % 64) / 2; }
__host__ __device__ __forceinline__ int perm32(int rho) { const int n = rho >> 4, i = rho & 15; return 8 * (i >> 2) + 4 * n + (i & 3); }
struct Unit { int pm, pn; };
struct Gemm { const bf16* A; const bf16* Bt; int M, N, K, lda, ldb; };
struct StaticOrder {
    int nM, nN, nwg, G, c, wgm;
    __device__ void init(int M, int N, int G_, int c_, int wgm_ = WGM) { nM = M / BM; nN = N / BM; nwg = nM * nN; G = G_; c = c_; wgm = wgm_; }
    __device__ bool next(int i, Unit& u) const {
        const long L = (long)i * G + c; if (L >= nwg) return false;
        int wgid = (int)L; { const int q = nwg / NXCD, r = nwg % NXCD, xcd = wgid % NXCD, off = wgid / NXCD; wgid = (xcd < r ? xcd * (q + 1) : r * (q + 1) + (xcd - r) * q) + off; }
        const int nig = wgm * nN, gid = wgid / nig, fm = gid * wgm, gsz = (nM - fm) < wgm ? (nM - fm) : wgm;
        u.pm = fm + ((wgid % nig) % gsz); u.pn = (wgid % nig) / gsz; return true;
    }
};
typedef int i32x8 __attribute__((ext_vector_type(8)));
typedef int i32x4 __attribute__((ext_vector_type(4)));
template <class T, class = void> struct IsI8 { static constexpr bool value = false; };
template <class T> struct IsI8<T, decltype((void)T::I8)> { static constexpr bool value = T::I8; };
template <class T, class = void> struct IsF8 { static constexpr bool value = false; };
template <class T> struct IsF8<T, decltype((void)T::F8)> { static constexpr bool value = T::F8; };
template <class T> __device__ __forceinline__ const T* sgpr_ptr(const T* p) { const unsigned long long v = (unsigned long long)p;
    const unsigned lo = __builtin_amdgcn_readfirstlane((unsigned)v), hi = __builtin_amdgcn_readfirstlane((unsigned)(v >> 32)); return (const T*)(((unsigned long long)hi << 32) | lo); }
template <class Epi>
__device__ __forceinline__ void gemm_phase(LAS unsigned char* lds, const Gemm g_in, const StaticOrder& S, const Epi& E) {
    Gemm g = g_in; g.A = sgpr_ptr(g_in.A); g.Bt = sgpr_ptr(g_in.Bt);
    int tid = threadIdx.x; asm volatile("" : "+v"(tid));
    const int wid = __builtin_amdgcn_readfirstlane(tid >> 6), lane = tid & 63, wr = wid >> 2, wc = wid & 3, fr = lane & 15, fq = lane >> 4;
    int nt = g.K / BK; asm volatile("" : "+s"(nt));
    unsigned voffA, voffB;
    { int R, C; stage_rc(tid * 16, R, C); const int Rb = Epi::PERM ? ((R & ~31) + perm32(R & 31)) : R;
      voffA = (unsigned)(R * g.lda + C) * 2u; voffB = (unsigned)(Rb * g.ldb + C) * 2u; }
    const size_t rsA = (size_t)64 * g.lda * 2, rsB = (size_t)64 * g.ldb * 2;
    const size_t kstep = (size_t)(BK * 2);
    const size_t hsA = (size_t)HALF * g.lda * 2, hsB = (size_t)HALF * g.ldb * 2, tsA = 2 * hsA, tsB = 2 * hsB;
    const unsigned ldsw = (unsigned)wid * 1024u;
    const int aoff = lds_byte(wr * 64 + fr, fq * 8), boff = lds_byte(wc * 32 + fr, fq * 8);
#define PG8_SA(b, h) (((b) * 2 + (h)) * HTB)
#define PG8_SB(b, h) ((4 + (b) * 2 + (h)) * HTB)
#define PG8_STAGE(bufoff, gbase, X) do { _Pragma("unroll") for (int _i = 0; _i < 2; ++_i) { \
        const char* gp_ = (const char*)(gbase) + (_i ? rs##X : (size_t)0); const unsigned la_ = (unsigned)(size_t)(lds + (bufoff) + ldsw + _i * 8192); \
        asm volatile("s_mov_b32 m0, %2\n\ts_nop 0\n\tglobal_load_lds_dwordx4 %0, %1" :: "v"(voff##X), "s"(gp_), "s"(la_) : "memory", "m0"); } } while (0)
#define PG8_LDA(dst, b, h) do { _Pragma("unroll") for (int m = 0; m < 4; ++m) _Pragma("unroll") for (int k = 0; k < 2; ++k) dst[m][k] = *(const LAS bf16x8*)(lds + PG8_SA(b, h) + aoff + m * 2048 + k * 1024); } while (0)
#define PG8_LDB(dst, b, h) do { _Pragma("unroll") for (int n = 0; n < 2; ++n) _Pragma("unroll") for (int k = 0; k < 2; ++k) dst[n][k] = *(const LAS bf16x8*)(lds + PG8_SB(b, h) + boff + n * 2048 + k * 1024); } while (0)
#ifdef F8_NMAJOR
#define F8_LOOP _Pragma("unroll") for (int n = 0; n < 2; ++n) _Pragma("unroll") for (int m = 0; m < 4; ++m)
#else
#define F8_LOOP _Pragma("unroll") for (int m = 0; m < 4; ++m) _Pragma("unroll") for (int n = 0; n < 2; ++n)
#endif
#define PG8_MMA(ai, bj, At, Bt) do { __builtin_amdgcn_s_setprio(1); \
        if constexpr (IsF8<Epi>::value) { i32x8 a8[4], b8[2]; \
            _Pragma("unroll") for (int m = 0; m < 4; ++m) a8[m] = __builtin_shufflevector(__builtin_bit_cast(i32x4, At[m][0]), __builtin_bit_cast(i32x4, At[m][1]), 0, 1, 2, 3, 4, 5, 6, 7); \
            _Pragma("unroll") for (int n = 0; n < 2; ++n) b8[n] = __builtin_shufflevector(__builtin_bit_cast(i32x4, Bt[n][0]), __builtin_bit_cast(i32x4, Bt[n][1]), 0, 1, 2, 3, 4, 5, 6, 7); \
            F8_LOOP asm volatile("v_mfma_f32_16x16x128_f8f6f4 %0, %1, %2, %0" : "+v"(acc[ai][bj][m][n]) : "v"(b8[n]), "v"(a8[m])); } \
        else if constexpr (IsI8<Epi>::value) { _Pragma("unroll") for (int m = 0; m < 4; ++m) _Pragma("unroll") for (int n = 0; n < 2; ++n) _Pragma("unroll") for (int k = 0; k < 2; ++k) \
            acc[ai][bj][m][n] = __builtin_bit_cast(f32x4, __builtin_amdgcn_mfma_i32_16x16x64_i8(__builtin_bit_cast(i32x4, Bt[n][k]), __builtin_bit_cast(i32x4, At[m][k]), __builtin_bit_cast(i32x4, acc[ai][bj][m][n]), 0, 0, 0)); } \
        else { _Pragma("unroll") for (int m = 0; m < 4; ++m) _Pragma("unroll") for (int n = 0; n < 2; ++n) _Pragma("unroll") for (int k = 0; k < 2; ++k) \
            acc[ai][bj][m][n] = __builtin_amdgcn_mfma_f32_16x16x32_bf16(Bt[n][k], At[m][k], acc[ai][bj][m][n], 0, 0, 0); } \
        __builtin_amdgcn_s_setprio(0); } while (0)
#define PG8_WAIT_V(n) asm volatile("s_waitcnt vmcnt(" #n ")" ::: "memory")
#define PG8_WAIT_L(n) asm volatile("s_waitcnt lgkmcnt(" #n ")" ::: "memory")
#define PG8_BAR __builtin_amdgcn_s_barrier()
#define PG8_SCHED __builtin_amdgcn_sched_barrier(0)
    Unit cur, nxt; int ui = 0;
    if (!S.next(0, cur)) return;
    f32x4 acc[2][2][4][2];
#pragma unroll
    for (int a = 0; a < 2; ++a)
#pragma unroll
        for (int b = 0; b < 2; ++b)
#pragma unroll
            for (int m = 0; m < 4; ++m)
#pragma unroll
                for (int n = 0; n < 2; ++n) acc[a][b][m][n] = (f32x4){0.f, 0.f, 0.f, 0.f};
    bf16x8 At[4][2], B0[2][2], B1[2][2];
    const char* cA = (const char*)g.A + (size_t)cur.pm * tsA; const char* cB = (const char*)g.Bt + (size_t)cur.pn * tsB;
    PG8_STAGE(PG8_SB(0, 0), cB, B); PG8_STAGE(PG8_SB(0, 1), cB + hsB, B); PG8_STAGE(PG8_SA(0, 0), cA, A); PG8_STAGE(PG8_SA(0, 1), cA + hsA, A);
    if (wr == 1) PG8_BAR;
    PG8_WAIT_V(2); PG8_BAR;
    PG8_STAGE(PG8_SB(1, 0), cB + kstep, B); PG8_STAGE(PG8_SA(1, 0), cA + kstep, A); PG8_STAGE(PG8_SB(1, 1), cB + hsB + kstep, B);
    PG8_WAIT_V(6); PG8_BAR;
    for (;;) {
        const bool has_next = S.next(ui + 1, nxt);
        const char* nA = has_next ? (const char*)g.A + (size_t)nxt.pm * tsA : cA; const char* nB = has_next ? (const char*)g.Bt + (size_t)nxt.pn * tsB : cB;
        for (int t = 0; t < nt; t += 2) {
            const bool last = (t == nt - 2);
            const char* a1 = cA + (size_t)(t + 1) * kstep;
            const char* a2 = last ? nA : cA + (size_t)(t + 2) * kstep; const char* b2 = last ? nB : cB + (size_t)(t + 2) * kstep;
            const char* a3 = a2 + kstep; const char* b3 = b2 + kstep;
            PG8_LDB(B0, 0, 0); PG8_LDB(B1, 0, 1); PG8_SCHED; PG8_LDA(At, 0, 0); PG8_STAGE(PG8_SA(1, 1), a1 + hsA, A);
            PG8_WAIT_V(8); PG8_WAIT_L(0); PG8_BAR; PG8_MMA(0, 0, At, B0); PG8_MMA(0, 1, At, B1); PG8_BAR; PG8_SCHED;
            PG8_LDA(At, 0, 1); PG8_STAGE(PG8_SB(0, 0), b2, B); PG8_STAGE(PG8_SB(0, 1), b2 + hsB, B); PG8_STAGE(PG8_SA(0, 0), a2, A);
            PG8_WAIT_V(8); PG8_WAIT_L(0); PG8_BAR; PG8_MMA(1, 0, At, B0); PG8_MMA(1, 1, At, B1); PG8_BAR; PG8_SCHED;
            PG8_LDB(B0, 1, 0); PG8_LDB(B1, 1, 1); PG8_SCHED; PG8_LDA(At, 1, 0); PG8_STAGE(PG8_SA(0, 1), a2 + hsA, A);
            PG8_WAIT_V(8); PG8_WAIT_L(0); PG8_BAR; PG8_MMA(0, 0, At, B0); PG8_MMA(0, 1, At, B1); PG8_BAR; PG8_SCHED;
            PG8_LDA(At, 1, 1); PG8_STAGE(PG8_SB(1, 0), b3, B); PG8_STAGE(PG8_SB(1, 1), b3 + hsB, B); PG8_STAGE(PG8_SA(1, 0), a3, A);
            PG8_WAIT_V(8); PG8_WAIT_L(0); PG8_BAR; PG8_MMA(1, 0, At, B0); PG8_MMA(1, 1, At, B1); PG8_BAR; PG8_SCHED;
        }
        if (wr == 0) PG8_BAR;
        if constexpr (IsF8<Epi>::value) asm volatile("s_nop 15\n\ts_nop 15" ::: "memory");
        E(acc, cur, wr, wc, fr, fq);
        if (!has_next) break;
#pragma unroll
        for (int a = 0; a < 2; ++a)
#pragma unroll
            for (int b = 0; b < 2; ++b)
#pragma unroll
                for (int m = 0; m < 4; ++m)
#pragma unroll
                    for (int n = 0; n < 2; ++n) acc[a][b][m][n] = (f32x4){0.f, 0.f, 0.f, 0.f};
        cur = nxt; cA = nA; cB = nB; ++ui;
        if (wr == 1) PG8_BAR;
    }
    PG8_WAIT_V(0);
    PG8_BAR;
#undef PG8_SA
#undef PG8_SB
#undef PG8_STAGE
#undef PG8_LDA
#undef PG8_LDB
#undef PG8_MMA
#undef PG8_WAIT_V
#undef PG8_WAIT_L
#undef PG8_BAR
#undef PG8_SCHED
}

template <int IN, bool OUT8> struct EpiSwiGLU {
    static constexpr bool PERM = true, F8 = (IN == 1), I8 = (IN == 2);
    bf16* H;
    __device__ __forceinline__ void operator()(const f32x4 (&acc)[2][2][4][2], const Unit& u, int wr, int wc, int fr, int fq) const {
        asm volatile("" : "+v"(fr), "+v"(fq));
        const int row0 = u.pm * BM + wr * 64 + fr, col0 = u.pn * 128 + wc * 32 + 8 * fq;
#pragma unroll
        for (int ai = 0; ai < 2; ++ai)
#pragma unroll
            for (int m = 0; m < 4; ++m) { bf16* rowp = H + (size_t)(row0 + ai * HALF + m * 16) * DFF + col0;
                float h[8];
#pragma unroll
                for (int n = 0; n < 2; ++n)
#pragma unroll
                    for (int j = 0; j < 4; ++j) { const float ga = acc[ai][0][m][n][j], ua = acc[ai][1][m][n][j];
                        const float gt = IN == 2 ? (float)__float_as_int(ga) * I8_DEQ : (IN == 1 ? ga * (1.f / W8SCALE) : ga), up = IN == 2 ? (float)__float_as_int(ua) * I8_DEQ : (IN == 1 ? ua * (1.f / W8SCALE) : ua); h[n * 4 + j] = gt * sigmoidf_(gt) * up; }
                if (OUT8) *(u32x2*)((unsigned char*)H + (size_t)(row0 + ai * HALF + m * 16) * DFF + col0) = (u32x2){pk4_f8(h[0], h[1], h[2], h[3]), pk4_f8(h[4], h[5], h[6], h[7])};
                else { u32x4 w; w.x = cvt_pk_bf16(h[0], h[1]); w.y = cvt_pk_bf16(h[2], h[3]); w.z = cvt_pk_bf16(h[4], h[5]); w.w = cvt_pk_bf16(h[6], h[7]);
                    *(u32x4*)rowp = w; } }
    }
};
template <bool SPLIT, int IN = 0> struct EpiResid {
    static constexpr bool PERM = true, F8 = (IN == 1), I8 = (IN == 2);
    bf16* out; const float* xp; const float* xs; const bf16* xb; float scale;
    __device__ __forceinline__ void operator()(const f32x4 (&acc)[2][2][4][2], const Unit& u, int wr, int wc, int fr, int fq) const {
        const int row0 = u.pm * BM + wr * 64 + fr, col0 = u.pn * BM + wc * 32 + 8 * fq;
#pragma unroll
        for (int ai = 0; ai < 2; ++ai) {
            if (u.pm * BM + ai * HALF < MR) {
                f32x4 bv[4][2][2];
#pragma unroll
                for (int m = 0; m < 4; ++m) { const int row = row0 + ai * HALF + m * 16;
                    if (SPLIT) { const float* bp = row < MPR ? xp + (size_t)row * D + col0 : xs + (size_t)(row - MPR) * D + col0;
#pragma unroll
                        for (int bj = 0; bj < 2; ++bj)
#pragma unroll
                            for (int n = 0; n < 2; ++n) bv[m][bj][n] = *(const f32x4*)(bp + bj * HALF + n * 4);
                    } else { const bf16* bp = xb + (size_t)row * D + col0;
#pragma unroll
                        for (int bj = 0; bj < 2; ++bj) { const u32x4 w = *(const u32x4*)(bp + bj * HALF);
                            bv[m][bj][0] = (f32x4){__uint_as_float(w.x << 16), __uint_as_float(w.x & 0xffff0000u), __uint_as_float(w.y << 16), __uint_as_float(w.y & 0xffff0000u)};
                            bv[m][bj][1] = (f32x4){__uint_as_float(w.z << 16), __uint_as_float(w.z & 0xffff0000u), __uint_as_float(w.w << 16), __uint_as_float(w.w & 0xffff0000u)}; } } }
#pragma unroll
                for (int m = 0; m < 4; ++m) { bf16* op = out + (size_t)(row0 + ai * HALF + m * 16) * D + col0;
#pragma unroll
                    for (int bj = 0; bj < 2; ++bj) { f32x4 a0 = acc[ai][bj][m][0], a1 = acc[ai][bj][m][1];
                        if (IN == 2) { a0 = __builtin_convertvector(__builtin_bit_cast(i32x4, a0), f32x4); a1 = __builtin_convertvector(__builtin_bit_cast(i32x4, a1), f32x4); }
                        const f32x4 v0 = bv[m][bj][0] * ALPHA + a0 * scale, v1 = bv[m][bj][1] * ALPHA + a1 * scale;
                        u32x4 w; w.x = cvt_pk_bf16(v0[0], v0[1]); w.y = cvt_pk_bf16(v0[2], v0[3]); w.z = cvt_pk_bf16(v1[0], v1[1]); w.w = cvt_pk_bf16(v1[2], v1[3]);
                        *(u32x4*)(op + bj * HALF) = w; } }
            } }
    }
};
struct EpiZ {
    static constexpr bool PERM = true;
    bf16 *zh, *zr, *zg;
    __device__ __forceinline__ void operator()(const f32x4 (&acc)[2][2][4][2], const Unit& u, int wr, int wc, int fr, int fq) const {
        bf16* base; int ld, colt;
        if (u.pn < 32) { base = zh; ld = LDZH; colt = u.pn * BM; } else if (u.pn < 59) { base = zr; ld = LDZR; colt = (u.pn - 32) * BM; } else { base = zg; ld = LDZG; colt = (u.pn - 59) * BM; }
        const int row0 = u.pm * BM + wr * 64 + fr, col0 = colt + wc * 32 + 8 * fq;
#pragma unroll
        for (int ai = 0; ai < 2; ++ai)
#pragma unroll
            for (int m = 0; m < 4; ++m) { bf16* rowp = base + (size_t)(row0 + ai * HALF + m * 16) * ld + col0;
#pragma unroll
                for (int bj = 0; bj < 2; ++bj) { const f32x4 v0 = acc[ai][bj][m][0], v1 = acc[ai][bj][m][1];
                    u32x4 w; w.x = cvt_pk_bf16(v0[0], v0[1]); w.y = cvt_pk_bf16(v0[2], v0[3]); w.z = cvt_pk_bf16(v1[0], v1[1]); w.w = cvt_pk_bf16(v1[2], v1[3]);
                    *(u32x4*)(rowp + bj * HALF) = w; } }
    }
};
template <bool I8_> struct EpiZr {
    static constexpr bool PERM = true, I8 = I8_;
    bf16 *zh, *zr, *zg;
    __device__ __forceinline__ void operator()(const f32x4 (&acc)[2][2][4][2], const Unit& u, int wr, int wc, int fr, int fq) const {
        asm volatile("" : "+v"(fr), "+v"(fq));
        bf16* base; int ld, colt; const int pn = u.pn;
        if (!I8_) { if (pn < 16) { base = zh; ld = LDZH; colt = (pn + 8) * BM; } else { base = zr; ld = LDZR; colt = (pn - 8) * BM; } }
        else { if (pn < 32) { base = zg; ld = LDZG; colt = pn * BM; } else if (pn < 40) { base = zh; ld = LDZH; colt = (pn - 32) * BM; } else if (pn < 48) { base = zh; ld = LDZH; colt = (pn - 16) * BM; } else { base = zr; ld = LDZR; colt = (pn - 48) * BM; } }
        const int row0 = u.pm * BM + wr * 64 + fr, col0 = colt + wc * 32 + 8 * fq;
#pragma unroll
        for (int ai = 0; ai < 2; ++ai)
#pragma unroll
            for (int m = 0; m < 4; ++m) { bf16* rowp = base + (size_t)(row0 + ai * HALF + m * 16) * ld + col0;
#pragma unroll
                for (int bj = 0; bj < 2; ++bj) { f32x4 v0 = acc[ai][bj][m][0], v1 = acc[ai][bj][m][1];
                    if (I8_) { v0 = __builtin_convertvector(__builtin_bit_cast(i32x4, v0), f32x4) * I8_DEQ; v1 = __builtin_convertvector(__builtin_bit_cast(i32x4, v1), f32x4) * I8_DEQ; }
                    u32x4 w; w.x = cvt_pk_bf16(v0[0], v0[1]); w.y = cvt_pk_bf16(v0[2], v0[3]); w.z = cvt_pk_bf16(v1[0], v1[1]); w.w = cvt_pk_bf16(v1[2], v1[3]);
                    *(u32x4*)(rowp + bj * HALF) = w; } }
    }
};
struct EpiZG8 {
    static constexpr bool PERM = true, I8 = true;
    bf16* zg;
    __device__ __forceinline__ void operator()(const f32x4 (&acc)[2][2][4][2], const Unit& u, int wr, int wc, int fr, int fq) const {
        asm volatile("" : "+v"(fr), "+v"(fq));
        const int row0 = u.pm * BM + wr * 64 + fr, col0 = u.pn * BM + wc * 32 + 8 * fq;
#pragma unroll
        for (int ai = 0; ai < 2; ++ai)
#pragma unroll
            for (int m = 0; m < 4; ++m) { bf16* rowp = zg + (size_t)(row0 + ai * HALF + m * 16) * LDZG + col0;
#pragma unroll
                for (int bj = 0; bj < 2; ++bj) { const f32x4 v0 = __builtin_convertvector(__builtin_bit_cast(i32x4, acc[ai][bj][m][0]), f32x4) * I8_DEQ, v1 = __builtin_convertvector(__builtin_bit_cast(i32x4, acc[ai][bj][m][1]), f32x4) * I8_DEQ;
                    u32x4 w; w.x = cvt_pk_bf16(v0[0], v0[1]); w.y = cvt_pk_bf16(v0[2], v0[3]); w.z = cvt_pk_bf16(v1[0], v1[1]); w.w = cvt_pk_bf16(v1[2], v1[3]);
                    *(u32x4*)(rowp + bj * HALF) = w; } }
    }
};
struct EpiLoraF32 {
    static constexpr bool PERM = true;
    bf16* out; const float* bias;
    __device__ __forceinline__ void operator()(const f32x4 (&acc)[2][2][4][2], const Unit& u, int wr, int wc, int fr, int fq) const {
        const int row0 = u.pm * BM + wr * 64 + fr, col0 = u.pn * BM + wc * 32 + 8 * fq;
#pragma unroll
        for (int bj = 0; bj < 2; ++bj) { const f32x4 b0 = *(const f32x4*)(bias + col0 + bj * HALF), b1 = *(const f32x4*)(bias + col0 + bj * HALF + 4);
#pragma unroll
            for (int ai = 0; ai < 2; ++ai)
#pragma unroll
                for (int m = 0; m < 4; ++m) { const f32x4 v0 = acc[ai][bj][m][0] + b0, v1 = acc[ai][bj][m][1] + b1;
                    u32x4 w; w.x = cvt_pk_bf16(v0[0], v0[1]); w.y = cvt_pk_bf16(v0[2], v0[3]); w.z = cvt_pk_bf16(v1[0], v1[1]); w.w = cvt_pk_bf16(v1[2], v1[3]);
                    *(u32x4*)(out + (size_t)(row0 + ai * HALF + m * 16) * DH + col0 + bj * HALF) = w; } }
    }
};
struct EpiBf16Plain {
    static constexpr bool PERM = true;
    bf16* O; int ldc;
    __device__ __forceinline__ void operator()(const f32x4 (&acc)[2][2][4][2], const Unit& u, int wr, int wc, int fr, int fq) const {
        const int row0 = u.pm * BM + wr * 64 + fr, col0 = u.pn * BM + wc * 32 + 8 * fq;
#pragma unroll
        for (int ai = 0; ai < 2; ++ai)
#pragma unroll
            for (int m = 0; m < 4; ++m) { bf16* rowp = O + (size_t)(row0 + ai * HALF + m * 16) * ldc + col0;
#pragma unroll
                for (int bj = 0; bj < 2; ++bj) { const f32x4 v0 = acc[ai][bj][m][0], v1 = acc[ai][bj][m][1];
                    u32x4 w; w.x = cvt_pk_bf16(v0[0], v0[1]); w.y = cvt_pk_bf16(v0[2], v0[3]); w.z = cvt_pk_bf16(v1[0], v1[1]); w.w = cvt_pk_bf16(v1[2], v1[3]);
                    *(u32x4*)(rowp + bj * HALF) = w; } }
    }
};
template <bool FIRST> struct EpiProj {
    static constexpr bool PERM = true;
    bf16* mb; const bf16* zg; int goff; unsigned char* m8;
    __device__ __forceinline__ void operator()(const f32x4 (&acc)[2][2][4][2], const Unit& u, int wr, int wc, int fr, int fq) const {
        const int row0 = u.pm * BM + wr * 64 + fr, col0 = u.pn * BM + wc * 32 + 8 * fq;
#pragma unroll
        for (int ai = 0; ai < 2; ++ai) {
            u32x4 gw[4][2], pw[4][2];
#pragma unroll
            for (int m = 0; m < 4; ++m) { const size_t r = (size_t)(row0 + ai * HALF + m * 16);
#pragma unroll
                for (int bj = 0; bj < 2; ++bj) { gw[m][bj] = *(const u32x4*)(zg + r * LDZG + goff + col0 + bj * HALF);
                    pw[m][bj] = (u32x4){0u, 0u, 0u, 0u}; if (!FIRST) pw[m][bj] = *(const u32x4*)(mb + r * D + col0 + bj * HALF); } }
#pragma unroll
            for (int m = 0; m < 4; ++m) { const size_t r = (size_t)(row0 + ai * HALF + m * 16);
#pragma unroll
                for (int bj = 0; bj < 2; ++bj) {
                    float o[8];
#pragma unroll
                    for (int q = 0; q < 4; ++q) { const unsigned gq = gw[m][bj][q], pq = pw[m][bj][q];
                        const float g0 = __uint_as_float(gq << 16), g1 = __uint_as_float(gq & 0xffff0000u), p0 = __uint_as_float(pq << 16), p1 = __uint_as_float(pq & 0xffff0000u);
                        const f32x4 a = acc[ai][bj][m][q >> 1]; const float a0 = a[(q & 1) * 2], a1 = a[(q & 1) * 2 + 1];
                        o[2 * q] = p0 + sigmoidf_(g0) * a0; o[2 * q + 1] = p1 + sigmoidf_(g1) * a1; }
                    if (FIRST) { u32x4 w; w.x = cvt_pk_bf16(o[0], o[1]); w.y = cvt_pk_bf16(o[2], o[3]); w.z = cvt_pk_bf16(o[4], o[5]); w.w = cvt_pk_bf16(o[6], o[7]);
                        *(u32x4*)(mb + r * D + col0 + bj * HALF) = w; }
                    else *(u32x2*)(m8 + r * D + col0 + bj * HALF) = (u32x2){pk4_i8(o[0], o[1], o[2], o[3], I8_MB), pk4_i8(o[4], o[5], o[6], o[7], I8_MB)}; } }
        }
    }
};
}
using pg8::i32x4;

template <int MODE = 0, class EpiE>
__device__ __forceinline__ void skinny_phase(LAS unsigned char* lds, const bf16* A, int lda, const bf16* Bt, int ldb, int K, const EpiE& epi) {
    int tid = threadIdx.x; asm volatile("" : "+v"(tid));
    const int w = __builtin_amdgcn_readfirstlane(tid >> 6), lane = tid & 63, fr = lane & 15, fq = lane >> 4;
    const int kw = K / 8;
    for (int pc = blockIdx.x; pc < 256; pc += gridDim.x) {
        const int rg = (pc >> 3) & 3, cg = (pc & 7) * 8 + (pc >> 5);
        const bf16* ap = A + (size_t)(MPR + 32 * rg + fr) * lda + w * kw + 8 * fq;
        const bf16* bp = Bt + (size_t)(64 * cg + fr) * ldb + w * kw + 8 * fq;
        const unsigned char* ap8 = (const unsigned char*)A + (size_t)(MPR + 32 * rg + fr) * lda + w * kw + 8 * fq;
        const unsigned char* bp8 = (const unsigned char*)Bt + (size_t)(64 * cg + fr) * ldb + w * kw + 8 * fq;
        f32x4 acc[2][4];
#pragma unroll
        for (int mt = 0; mt < 2; ++mt)
#pragma unroll
            for (int nt = 0; nt < 4; ++nt) acc[mt][nt] = (f32x4){0.f, 0.f, 0.f, 0.f};
#pragma unroll 4
        for (int k0 = 0; k0 < kw; k0 += 32) {
            if constexpr (MODE == 2) { if (k0 & 32) continue;
                i32x4 ai[2], bi[4];
#pragma unroll
                for (int mt = 0; mt < 2; ++mt) ai[mt] = *(const i32x4*)(ap8 + (size_t)(16 * mt) * lda + k0 + 8 * fq);
#pragma unroll
                for (int nt = 0; nt < 4; ++nt) bi[nt] = *(const i32x4*)(bp8 + (size_t)(16 * nt) * ldb + k0 + 8 * fq);
#pragma unroll
                for (int mt = 0; mt < 2; ++mt)
#pragma unroll
                    for (int nt = 0; nt < 4; ++nt) acc[mt][nt] = __builtin_bit_cast(f32x4, __builtin_amdgcn_mfma_i32_16x16x64_i8(bi[nt], ai[mt], __builtin_bit_cast(i32x4, acc[mt][nt]), 0, 0, 0));
                continue; }
            if constexpr (MODE == 1) { long a8[2], b8[4];
#pragma unroll
                for (int mt = 0; mt < 2; ++mt) a8[mt] = *(const long*)(ap8 + (size_t)(16 * mt) * lda + k0);
#pragma unroll
                for (int nt = 0; nt < 4; ++nt) b8[nt] = *(const long*)(bp8 + (size_t)(16 * nt) * ldb + k0);
#pragma unroll
                for (int mt = 0; mt < 2; ++mt)
#pragma unroll
                    for (int nt = 0; nt < 4; ++nt) acc[mt][nt] = __builtin_amdgcn_mfma_f32_16x16x32_fp8_fp8(b8[nt], a8[mt], acc[mt][nt], 0, 0, 0);
                continue; }
            bf16x8 af[2], bfr[4];
#pragma unroll
            for (int mt = 0; mt < 2; ++mt) af[mt] = *(const bf16x8*)(ap + (size_t)(16 * mt) * lda + k0);
#pragma unroll
            for (int nt = 0; nt < 4; ++nt) bfr[nt] = *(const bf16x8*)(bp + (size_t)(16 * nt) * ldb + k0);
#pragma unroll
            for (int mt = 0; mt < 2; ++mt)
#pragma unroll
                for (int nt = 0; nt < 4; ++nt) acc[mt][nt] = __builtin_amdgcn_mfma_f32_16x16x32_bf16(bfr[nt], af[mt], acc[mt][nt], 0, 0, 0);
        }
        if constexpr (MODE == 2) {
#pragma unroll
            for (int mt = 0; mt < 2; ++mt)
#pragma unroll
                for (int nt = 0; nt < 4; ++nt) acc[mt][nt] = __builtin_convertvector(__builtin_bit_cast(i32x4, acc[mt][nt]), f32x4); }
        LAS float* red = (LAS float*)(lds + w * 8192);
#pragma unroll
        for (int mt = 0; mt < 2; ++mt)
#pragma unroll
            for (int nt = 0; nt < 4; ++nt) *(LAS f32x4*)(red + (16 * mt + fr) * 64 + 16 * nt + 4 * fq) = acc[mt][nt];
        __syncthreads();
        { const int m = tid >> 4, n4 = (tid & 15) * 4; f32x4 sum = (f32x4){0.f, 0.f, 0.f, 0.f};
#pragma unroll
          for (int ww = 0; ww < 8; ++ww) sum = sum + *(const LAS f32x4*)((const LAS float*)(lds + ww * 8192) + m * 64 + n4);
          epi(MPR + 32 * rg + m, 64 * cg + n4, sum); }
        __syncthreads();
    }
}
struct SkResidSplit { bf16* out; const float* xs; float scale;
    __device__ __forceinline__ void operator()(int row, int col, f32x4 a) const { const f32x4 b = *(const f32x4*)(xs + (size_t)(row - MPR) * D + col); const f32x4 t = b * ALPHA + a * scale;
        *(u32x2*)(out + (size_t)row * D + col) = (u32x2){pk2(t[0], t[1]), pk2(t[2], t[3])}; } };
struct SkResidBf { bf16* out; const bf16* xb; float scale;
    __device__ __forceinline__ void operator()(int row, int col, f32x4 a) const { const u32x2 w = *(const u32x2*)(xb + (size_t)row * D + col);
        const f32x4 b = (f32x4){__uint_as_float(w.x << 16), __uint_as_float(w.x & 0xffff0000u), __uint_as_float(w.y << 16), __uint_as_float(w.y & 0xffff0000u)}; const f32x4 t = b * ALPHA + a * scale;
        *(u32x2*)(out + (size_t)row * D + col) = (u32x2){pk2(t[0], t[1]), pk2(t[2], t[3])}; } };
template <bool FIRST> struct SkProj { bf16* mb; const bf16* zg; int goff; unsigned char* m8;
    __device__ __forceinline__ void operator()(int row, int col, f32x4 a) const {
        const u32x2 gw = *(const u32x2*)(zg + (size_t)row * LDZG + goff + col); u32x2 pw = (u32x2){0u, 0u}; if (!FIRST) pw = *(const u32x2*)(mb + (size_t)row * D + col);
        const float g0 = __uint_as_float(gw.x << 16), g1 = __uint_as_float(gw.x & 0xffff0000u), g2 = __uint_as_float(gw.y << 16), g3 = __uint_as_float(gw.y & 0xffff0000u);
        const float p0 = __uint_as_float(pw.x << 16), p1 = __uint_as_float(pw.x & 0xffff0000u), p2 = __uint_as_float(pw.y << 16), p3 = __uint_as_float(pw.y & 0xffff0000u);
        const float o0 = p0 + sigmoidf_(g0) * a[0], o1 = p1 + sigmoidf_(g1) * a[1], o2 = p2 + sigmoidf_(g2) * a[2], o3 = p3 + sigmoidf_(g3) * a[3];
        if (FIRST) *(u32x2*)(mb + (size_t)row * D + col) = (u32x2){pk2(o0, o1), pk2(o2, o3)};
        else *(unsigned*)(m8 + (size_t)row * D + col) = pk4_i8(o0, o1, o2, o3, I8_MB); } };

#define XB_TMO      128
#define XB_XCNT(j)  (256  + 64 * (j))
#define XB_XSUB(j)  (1280 + 64 * (j))
#define XB_XGEN(j)  (2304 + 64 * (j))
#define XB_TOP      3328
#define XB_TOPGEN   3392
#define XCD_BAR_WORDS 3456
#define XB_SPIN_CAP (1u << 20)
__device__ __forceinline__ unsigned xb_ld(unsigned* p)              { return __hip_atomic_load(p, __ATOMIC_RELAXED, __HIP_MEMORY_SCOPE_AGENT); }
__device__ __forceinline__ unsigned xb_add(unsigned* p, unsigned v) { return __hip_atomic_fetch_add(p, v, __ATOMIC_RELAXED, __HIP_MEMORY_SCOPE_AGENT); }
__device__ __forceinline__ unsigned xb_xcc_id() { return (unsigned)__builtin_amdgcn_s_getreg((3 << 11) | 20) & 0xFu; }
#define XB_SPIN(cond, bar) do { unsigned _sp = 0; while (cond) { __builtin_amdgcn_s_sleep(1); \
    if ((++_sp & 255u) == 0u) { if (xb_ld(&(bar)[XB_TMO])) break; if (_sp > XB_SPIN_CAP) { atomicAdd(&(bar)[XB_TMO], 1u); break; } } } } while (0)
struct XcdBarrier { unsigned* bar; unsigned x; volatile LAS unsigned* st; };
__device__ __forceinline__ XcdBarrier xcd_barrier_post(unsigned* bar, volatile LAS unsigned* st) {
    XcdBarrier b; b.bar = bar; b.x = xb_xcc_id(); b.st = st;
    if (threadIdx.x == 0) (void)xb_add(&bar[XB_XCNT(b.x)], 1u);
    return b;
}
__device__ __forceinline__ void xcd_barrier_complete(unsigned* bar, unsigned x, unsigned& nloc, unsigned& nx) {
    const unsigned G = gridDim.x * gridDim.y * gridDim.z;
    unsigned sum, cnt, mine, sp = 0u;
    for (;;) {
        sum = 0u; cnt = 0u; mine = 0u;
#pragma unroll
        for (unsigned j = 0; j < 16; ++j) { const unsigned c = xb_ld(&bar[XB_XCNT(j)]); sum += c; cnt += (c > 0u) ? 1u : 0u; mine = (j == x) ? c : mine; }
        if (sum == G) break;
        __builtin_amdgcn_s_sleep(1);
        if ((++sp & 255u) == 0u) { if (xb_ld(&bar[XB_TMO])) break; if (sp > XB_SPIN_CAP) { atomicAdd(&bar[XB_TMO], 1u); break; } }
    }
    nloc = mine > 0u ? mine : 1u; nx = cnt > 0u ? cnt : 1u;
}
__device__ __forceinline__ void xcd_barrier(const XcdBarrier& b) {
    asm volatile("s_waitcnt vmcnt(0)" ::: "memory");
    __syncthreads();
    if (threadIdx.x == 0) {
        unsigned* bar = b.bar;
        __builtin_amdgcn_s_waitcnt(0);
        unsigned nloc = b.st[0], nx = b.st[1];
        if (nloc == 0u) { xcd_barrier_complete(bar, b.x, nloc, nx); b.st[0] = nloc; b.st[1] = nx; }
        const unsigned old = xb_add(&bar[XB_XSUB(b.x)], 1u);
        const unsigned gen = old / nloc;
        if (old + 1u == (gen + 1u) * nloc) {
            __builtin_amdgcn_fence(__ATOMIC_RELEASE, "agent");
            asm volatile("s_waitcnt vmcnt(0)" ::: "memory");
            const unsigned og = xb_add(&bar[XB_TOP], 1u);
            const unsigned tg = og / nx;
            if (og + 1u == (tg + 1u) * nx) xb_add(&bar[XB_TOPGEN], 1u);
            else XB_SPIN(xb_ld(&bar[XB_TOPGEN]) == tg, bar);
            __builtin_amdgcn_fence(__ATOMIC_ACQUIRE, "agent");
            xb_add(&bar[XB_XGEN(b.x)], 1u);
            asm volatile("s_waitcnt vmcnt(0)" ::: "memory");
        } else {
            XB_SPIN(xb_ld(&bar[XB_XGEN(b.x)]) == gen, bar);
            __builtin_amdgcn_fence(__ATOMIC_ACQUIRE, "agent");
            asm volatile("s_waitcnt vmcnt(0)" ::: "memory");
        }
    }
    __syncthreads();
}

struct Params {
    const float* in[32];
    float* out; unsigned char* ws;
};
struct Frame {
    LAS unsigned char* lds;
    int tid, lane, wave, G, gw, NGW;
    const float* const* in; float* out; unsigned char* ws;
};
#define LDS_WAIT() asm volatile("s_waitcnt lgkmcnt(0)" ::: "memory")
__device__ __forceinline__ float wave_sum(float v) {
#pragma unroll
    for (int o = 1; o < 64; o <<= 1) v += __shfl_xor(v, o);
    return v;
}
enum { I_XP = 0, I_XS, I_SHG, I_SRW, I_SSH, I_LN1G, I_LN1B, I_F1IN, I_F1DN, I_LN2G, I_LN2B, I_WIN, I_HGLB, I_HGNG, I_HGPROJ, I_MU, I_W0, I_W2, I_A0, I_A2, I_G2,
       I_KK, I_KA, I_RK, I_LNG, I_LNB, I_RWPROJ, I_WOUT, I_LN3G, I_LN3B, I_F2IN, I_F2DN };

template <int MAP>
__device__ __forceinline__ void transpose_item(const float* W, int K, int N, int ldw, bf16* WT, LAS float* scr, int item, int lane) {
    const int nblk = N / 32, kb = item / nblk, nb = item % nblk, k0 = 64 * kb, n0 = 32 * nb;
    int dr0 = n0;
    if (MAP == 1) { if (n0 < DFF) dr0 = (n0 >> 7) * 256 + (n0 & 127); else { const int uo = n0 - DFF; dr0 = (uo >> 7) * 256 + 128 + (uo & 127); } }
#pragma unroll 8
    for (int i = 0; i < 32; ++i) { const int kk = 2 * i + (lane >> 5); scr[kk * 33 + (lane & 31)] = W[(size_t)(k0 + kk) * ldw + n0 + (lane & 31)]; }
    LDS_WAIT(); asm volatile("" ::: "memory");
    const int c = lane & 7;
#pragma unroll
    for (int j = 0; j < 4; ++j) { const int n = (lane >> 3) + 8 * j; const LAS float* s = scr + (8 * c) * 33 + n;
        u32x4 o; o.x = pk2(s[0 * 33], s[1 * 33]); o.y = pk2(s[2 * 33], s[3 * 33]); o.z = pk2(s[4 * 33], s[5 * 33]); o.w = pk2(s[6 * 33], s[7 * 33]);
        *(u32x4*)(WT + (size_t)(dr0 + n) * K + k0 + 8 * c) = o; }
    LDS_WAIT(); asm volatile("" ::: "memory");
}
template <int MAP, bool QI8 = false>
__device__ __forceinline__ void transpose_f8_matrix(Frame& F, const float* W, int K, int N, unsigned char* WT, float scl, int ldw = 0) {
    if (ldw == 0) ldw = N;
    LAS float* scr = (LAS float*)(F.lds + F.wave * 16384); const int lane = F.lane;
    const int nblk = N / 32, nitems = (K / 64) * nblk;
    for (int item = F.gw; item < nitems; item += F.NGW) { const int kb = item / nblk, nb = item % nblk, k0 = 64 * kb, n0 = 32 * nb;
        int dr0 = n0; if (MAP == 1) { if (n0 < DFF) dr0 = (n0 >> 7) * 256 + (n0 & 127); else { const int uo = n0 - DFF; dr0 = (uo >> 7) * 256 + 128 + (uo & 127); } }
#pragma unroll 8
        for (int i = 0; i < 32; ++i) { const int kk = 2 * i + (lane >> 5); scr[kk * 33 + (lane & 31)] = W[(size_t)(k0 + kk) * ldw + n0 + (lane & 31)]; }
        LDS_WAIT(); asm volatile("" ::: "memory");
        const int c = lane & 3;
#pragma unroll
        for (int j = 0; j < 2; ++j) { const int n = (lane >> 2) + 16 * j; const LAS float* sp = scr + (16 * c) * 33 + n;
            u32x4 o;
            if (QI8) { o.x = pk4_i8(sp[0 * 33], sp[1 * 33], sp[2 * 33], sp[3 * 33], scl); o.y = pk4_i8(sp[4 * 33], sp[5 * 33], sp[6 * 33], sp[7 * 33], scl);
                o.z = pk4_i8(sp[8 * 33], sp[9 * 33], sp[10 * 33], sp[11 * 33], scl); o.w = pk4_i8(sp[12 * 33], sp[13 * 33], sp[14 * 33], sp[15 * 33], scl); }
            else {
            o.x = pk4_f8(sp[0 * 33] * scl, sp[1 * 33] * scl, sp[2 * 33] * scl, sp[3 * 33] * scl); o.y = pk4_f8(sp[4 * 33] * scl, sp[5 * 33] * scl, sp[6 * 33] * scl, sp[7 * 33] * scl);
            o.z = pk4_f8(sp[8 * 33] * scl, sp[9 * 33] * scl, sp[10 * 33] * scl, sp[11 * 33] * scl); o.w = pk4_f8(sp[12 * 33] * scl, sp[13 * 33] * scl, sp[14 * 33] * scl, sp[15 * 33] * scl); }
            *(u32x4*)(WT + (size_t)(dr0 + n) * K + k0 + 16 * c) = o; }
        LDS_WAIT(); asm volatile("" ::: "memory"); }
}
template <int MAP>
__device__ __forceinline__ void transpose_matrix(Frame& F, const float* W, int K, int N, bf16* WT, int ldw = 0) {
    LAS float* scr = (LAS float*)(F.lds + F.wave * 16384); if (ldw == 0) ldw = N;
    const int nitems = (K / 64) * (N / 32);
    for (int it = F.gw; it < nitems; it += F.NGW) transpose_item<MAP>(W, K, N, ldw, WT, scr, it, F.lane);
}
__device__ __forceinline__ void lora_weight(Frame& F, const float* W, int KR, int KP, bf16* dst) {
    const int total = 2048 * KP; const int gt = blockIdx.x * 512 + F.tid, NT = F.G * 512;
    for (int e = gt; e < total; e += NT) { const int n = e / KP, k = e % KP; dst[e] = (bf16)(k < KR ? f2bf(W[(size_t)k * 2048 + n]) : 0u); }
}
__device__ __forceinline__ void p0_prologue(Frame& F) {
    { unsigned char* x8 = F.ws + WS_XB8; const float* xp = F.in[I_XP]; const float* xs = F.in[I_XS];
      const size_t total8 = (size_t)MP * D / 8; const size_t gt = (size_t)blockIdx.x * 512 + F.tid, NT = (size_t)F.G * 512;
      for (size_t e = gt; e < total8; e += NT) { const size_t el = e * 8; const int row = (int)(el / D);
          u32x2 o = (u32x2){0u, 0u};
          if (row < MR) { const float* src = row < MPR ? xp + el : xs + (el - (size_t)MPR * D); const f32x4 a = *(const f32x4*)src, b = *(const f32x4*)(src + 4);
              o.x = pk4_i8(a[0], a[1], a[2], a[3], I8_ACT); o.y = pk4_i8(b[0], b[1], b[2], b[3], I8_ACT); }
          *(u32x2*)(x8 + el) = o; } }
    transpose_f8_matrix<1, true>(F, F.in[I_F1IN], D, NFF, F.ws + WS_WFI, I8_W);
    transpose_f8_matrix<0>(F, F.in[I_F1DN], DFF, D, F.ws + WS_WFD, pg8::W8SCALE_DN);
    { const int ldw = 8192 + DRIN + 8192; const float* W = F.in[I_WIN]; bf16* wb = (bf16*)(F.ws + WS_WIN); unsigned char* w8 = F.ws + WS_WIN8;
      transpose_matrix<0>(F, W + 2048, D, 4096, wb, ldw);
      transpose_matrix<0>(F, W + 8192 + 2048, D, DRIN - 2048, wb + (size_t)4096 * D, ldw);
      transpose_f8_matrix<0, true>(F, W + 8192 + DRIN, D, 8192, w8, I8_W, ldw);
      transpose_f8_matrix<0, true>(F, W, D, 2048, w8 + (size_t)8192 * D, I8_W, ldw);
      transpose_f8_matrix<0, true>(F, W + 6144, D, 2048, w8 + (size_t)10240 * D, I8_W, ldw);
      transpose_f8_matrix<0, true>(F, W + 8192, D, 2048, w8 + (size_t)12288 * D, I8_W, ldw); }
    { bf16* wz = (bf16*)(F.ws + WS_WIN) + (size_t)(4096 + DRIN - 2048) * D; const int total8 = 32 * D / 8; const int gt = blockIdx.x * 512 + F.tid;
      for (int e = gt; e < total8; e += F.G * 512) *(u32x4*)(wz + (size_t)e * 8) = (u32x4){0u, 0u, 0u, 0u}; }
    transpose_matrix<0>(F, F.in[I_HGPROJ], DH, D, (bf16*)(F.ws + WS_HGP));
    transpose_matrix<0>(F, F.in[I_RWPROJ], DH, D, (bf16*)(F.ws + WS_RWP));
    transpose_f8_matrix<0, true>(F, F.in[I_WOUT], D, D, F.ws + WS_WOUT, I8_WOUT);
    lora_weight(F, F.in[I_W2], 128, 256, (bf16*)(F.ws + WS_LW2));
    lora_weight(F, F.in[I_A2], 128, 256, (bf16*)(F.ws + WS_LA2));
    lora_weight(F, F.in[I_G2], 480, 512, (bf16*)(F.ws + WS_LG2));
}
template <bool WRITE_BF, bool WRITE_F32, bool WRITE_F8 = false>
__device__ __forceinline__ void ln_phase(Frame& F, const bf16* T, const float* g, const float* b, unsigned char* x8 = nullptr) {
    float* Y = F.out; bf16* xb = (bf16*)(F.ws + WS_XB);
    int lane_ = threadIdx.x & 63; asm volatile("" : "+v"(lane_));
    for (int row = F.gw; row < MR; row += F.NGW) {
        const u32x4* tr = (const u32x4*)(T + (size_t)row * D) + lane_;
        float v[64]; float s = 0.f;
#pragma unroll
        for (int j = 0; j < 8; ++j) { const u32x4 w = tr[64 * j];
#pragma unroll
            for (int q = 0; q < 4; ++q) { v[8 * j + 2 * q] = __uint_as_float(w[q] << 16); v[8 * j + 2 * q + 1] = __uint_as_float(w[q] & 0xffff0000u); s += v[8 * j + 2 * q] + v[8 * j + 2 * q + 1]; } }
        const float mean = wave_sum(s) * (1.f / D); float s2 = 0.f;
#pragma unroll
        for (int i = 0; i < 64; ++i) { v[i] -= mean; s2 += v[i] * v[i]; }
        const float rstd = 1.f / sqrtf(wave_sum(s2) * (1.f / D) + 1e-5f);
#pragma unroll
        for (int j = 0; j < 8; ++j) { const int c0 = 8 * (lane_ + 64 * j);
            const f32x4 g0 = *(const f32x4*)(g + c0), g1 = *(const f32x4*)(g + c0 + 4), b0 = *(const f32x4*)(b + c0), b1 = *(const f32x4*)(b + c0 + 4);
            const f32x4 y0 = (f32x4){v[8 * j], v[8 * j + 1], v[8 * j + 2], v[8 * j + 3]} * rstd * g0 + b0, y1 = (f32x4){v[8 * j + 4], v[8 * j + 5], v[8 * j + 6], v[8 * j + 7]} * rstd * g1 + b1;
            if (WRITE_F32) { *(f32x4*)(Y + (size_t)row * D + c0) = y0; *(f32x4*)(Y + (size_t)row * D + c0 + 4) = y1; }
            if (WRITE_BF) *(u32x4*)(xb + (size_t)row * D + c0) = (u32x4){pk2(y0[0], y0[1]), pk2(y0[2], y0[3]), pk2(y1[0], y1[1]), pk2(y1[2], y1[3])};
            if (WRITE_F8) *(u32x2*)(x8 + (size_t)row * D + c0) = (u32x2){pk4_i8(y0[0], y0[1], y0[2], y0[3], I8_ACT), pk4_i8(y1[0], y1[1], y1[2], y1[3], I8_ACT)}; }
    }
}

#define MFMA32(a, b, c) __builtin_amdgcn_mfma_f32_32x32x16_bf16((a), (b), (c), 0, 0, 0)
__device__ __forceinline__ void hg_decode(int u, int& h, int& row0, int& nvalid) {
    h = u & 15;
    if (u < 4096) { row0 = (u >> 4) * 64; nvalid = 64; } else { row0 = MPR + ((u - 4096) >> 4) * 16; nvalid = 16; }
}
__device__ __forceinline__ void hg_pass1(Frame& F) {
    LAS unsigned char* L = F.lds;
    LAS bf16* QT = (LAS bf16*)(L); LAS bf16* KT = (LAS bf16*)(L + 17408); LAS bf16* KET = (LAS bf16*)(L + 34816); LAS bf16* VT = (LAS bf16*)(L + 53248); LAS bf16* PP = (LAS bf16*)(L + 71680);
    LAS float* SEG = (LAS float*)(L + 80896);
    const bf16* ZH = (const bf16*)(F.ws + WS_ZH);
    bf16* OI = (bf16*)(F.ws + WS_OI); bf16* UT = (bf16*)(F.ws + WS_UT); bf16* Q0 = (bf16*)(F.ws + WS_Q0); float* ADEC = (float*)(F.ws + WS_ADEC);
    const float* hglb = F.in[I_HGLB];
    const int tid = F.tid, d = tid & 127, seg = tid >> 7, w = F.wave, lane = F.lane, r = lane & 31, hh = lane >> 5;
    bf16 rq[16], rf[16], ri[16];
#define HG1_LOAD(uu) do { int h_, r0_, nv_; hg_decode((uu), h_, r0_, nv_); const bf16* zq_ = ZH + (size_t)r0_ * LDZH + h_ * 128 + d; \
        _Pragma("unroll") for (int i = 0; i < 16; ++i) { const int t_ = seg * 16 + i; const int tc_ = t_ < nv_ ? t_ : 0;        \
            rq[i] = zq_[(size_t)tc_ * LDZH]; rf[i] = zq_[(size_t)tc_ * LDZH + 2048]; ri[i] = zq_[(size_t)tc_ * LDZH + 4096]; } } while (0)
    if ((int)blockIdx.x < HGU) HG1_LOAD((int)blockIdx.x);
    for (int u = blockIdx.x; u < HGU; u += F.G) {
        int h, row0, nvalid; hg_decode(u, h, row0, nvalid);
        const int hd = h * 128 + d;
        const float lb = sigmoidf_(hglb[hd] - hglb[2048 + hd]);
        float q[16], kf[16], Lc[16], vv[16]; float run = 0.f;
#pragma unroll
        for (int i = 0; i < 16; ++i) { const int t = seg * 16 + i; const bool valid = t < nvalid;
            const float qv = valid ? bf2f(rq[i]) : 0.f; float fp = valid ? bf2f(rf[i]) : 0.f; const float iv = valid ? bf2f(ri[i]) : 0.f;
            fp = fminf(fmaxf(fp, -30.f), 30.f);
            const float e = __expf(-fp), sg = __builtin_amdgcn_rcpf(1.f + e), sgn = e * sg;
            const float f = lb + (1.f - lb) * sg;
            const float lf = valid ? __logf(f) : 0.f;
            run += lf; Lc[i] = run; q[i] = qv; kf[i] = valid ? (1.f - lb) * sgn : 0.f; vv[i] = iv; }
        { const int un = u + F.G < HGU ? u + F.G : u; HG1_LOAD(un); }
        SEG[seg * 128 + d] = run;
        __syncthreads();
        const float s0 = SEG[d], s1 = SEG[128 + d], s2 = SEG[256 + d], s3 = SEG[384 + d];
        const float base = (seg > 0 ? s0 : 0.f) + (seg > 1 ? s1 : 0.f) + (seg > 2 ? s2 : 0.f);
        const float Lm = s0 + s1, Lend = Lm + s2 + s3;
        const float eLm = __expf(Lm), eEnd = __expf(Lend - Lm);
        unsigned kep[8], vtp[8];
#pragma unroll
        for (int i = 0; i < 16; i += 2) {
            float ke2[2];
#pragma unroll
            for (int ii = 0; ii < 2; ++ii) { const int t = seg * 16 + i + ii; const float Lt = base + Lc[i + ii];
                const float e1 = __expf(Lt - Lm), e2 = __expf(Lm - Lt);
                const float qt = q[i + ii] * e1, kt = kf[i + ii] * e2;
                QT[t * 136 + d] = (bf16)f2bf(qt); KT[t * 136 + d] = (bf16)f2bf(kt);
                if (t < nvalid) Q0[(size_t)(row0 + t) * DH + hd] = (bf16)f2bf(qt * eLm);
                ke2[ii] = kt * eEnd; }
            kep[i >> 1] = pk2(ke2[0], ke2[1]); vtp[i >> 1] = pk2(vv[i], vv[i + 1]); }
        *(LAS u32x4*)(KET + d * 72 + seg * 16) = (u32x4){kep[0], kep[1], kep[2], kep[3]}; *(LAS u32x4*)(KET + d * 72 + seg * 16 + 8) = (u32x4){kep[4], kep[5], kep[6], kep[7]};
        *(LAS u32x4*)(VT + d * 72 + seg * 16) = (u32x4){vtp[0], vtp[1], vtp[2], vtp[3]}; *(LAS u32x4*)(VT + d * 72 + seg * 16 + 8) = (u32x4){vtp[4], vtp[5], vtp[6], vtp[7]};
        if (seg == 0) ADEC[(size_t)u * 128 + d] = __expf(Lend);
        __syncthreads();
        if (w < 4) { const int ts = w >> 1, tt = w & 1;
            f32x16 acc; for (int i = 0; i < 16; ++i) acc[i] = 0.f;
            if (!(ts == 1 && tt == 0)) {
#pragma unroll
                for (int ks = 0; ks < 8; ++ks) { const bf16x8 a = *(const LAS bf16x8*)(KT + (32 * ts + r) * 136 + 16 * ks + 8 * hh), b = *(const LAS bf16x8*)(QT + (32 * tt + r) * 136 + 16 * ks + 8 * hh);
                    acc = MFMA32(a, b, acc); } }
            const int t = 32 * tt + r;
#pragma unroll
            for (int g = 0; g < 4; ++g) { const int sb = 32 * ts + 8 * g + 4 * hh; float p[4];
#pragma unroll
                for (int j = 0; j < 4; ++j) p[j] = (sb + j <= t) ? acc[4 * g + j] : 0.f;
                *(LAS u32x2*)(PP + t * 72 + sb) = (u32x2){pk2(p[0], p[1]), pk2(p[2], p[3])}; } }
        __syncthreads();
        { const int tv = w >> 1, tt = w & 1; f32x16 acc; for (int i = 0; i < 16; ++i) acc[i] = 0.f;
#pragma unroll
          for (int ks = 0; ks < 4; ++ks) { const bf16x8 a = *(const LAS bf16x8*)(VT + (32 * tv + r) * 72 + 16 * ks + 8 * hh), b = *(const LAS bf16x8*)(PP + (32 * tt + r) * 72 + 16 * ks + 8 * hh);
              acc = MFMA32(a, b, acc); }
          const int t = 32 * tt + r;
          if (t < nvalid) { bf16* op = OI + (size_t)(row0 + t) * DH + h * 128 + 32 * tv + 4 * hh;
#pragma unroll
              for (int g = 0; g < 4; ++g) *(u32x2*)(op + 8 * g) = (u32x2){pk2(acc[4 * g], acc[4 * g + 1]), pk2(acc[4 * g + 2], acc[4 * g + 3])}; } }
#pragma unroll
        for (int x = 0; x < 2; ++x) { const int td = w >> 1, tv = 2 * (w & 1) + x; f32x16 acc; for (int i = 0; i < 16; ++i) acc[i] = 0.f;
#pragma unroll
            for (int ks = 0; ks < 4; ++ks) { const bf16x8 a = *(const LAS bf16x8*)(KET + (32 * td + r) * 72 + 16 * ks + 8 * hh), b = *(const LAS bf16x8*)(VT + (32 * tv + r) * 72 + 16 * ks + 8 * hh);
                acc = MFMA32(a, b, acc); }
            bf16* up = UT + ((size_t)u * 128 + 32 * tv + r) * 128 + 32 * td + 4 * hh;
#pragma unroll
            for (int g = 0; g < 4; ++g) *(u32x2*)(up + 8 * g) = (u32x2){pk2(acc[4 * g], acc[4 * g + 1]), pk2(acc[4 * g + 2], acc[4 * g + 3])}; }
        __syncthreads();
    }
#undef HG1_LOAD
}
__device__ __forceinline__ void hg_pass2(Frame& F) {
    const bf16* UT = (const bf16*)(F.ws + WS_UT); const float* ADEC = (const float*)(F.ws + WS_ADEC); bf16* ST = (bf16*)(F.ws + WS_ST);
#define UT2(p) ({ const unsigned w_ = *(const unsigned*)(p); (f32x2){__uint_as_float(w_ << 16), __uint_as_float(w_ & 0xffff0000u)}; })
    const int gt = blockIdx.x * 512 + F.tid, NT = F.G * 512;
    LAS float* AD = (LAS float*)F.lds;
    const size_t cst = (size_t)16 * 128 * 128;
    for (int e0 = blockIdx.x * 512; e0 < 16 * 128 * 64; e0 += NT) { const int e = e0 + F.tid, dp = e & 63, v = (e >> 6) & 127, h = e0 >> 13, d = 2 * dp;
        const bf16* up = UT + ((size_t)h * 128 + v) * 128 + d; bf16* sp = ST + ((size_t)h * 128 + v) * 128 + d;
        unsigned ring[16];
#pragma unroll
        for (int q = 0; q < 16; ++q) ring[q] = *(const unsigned*)(up + (size_t)q * cst);
        for (int i = F.tid; i < 256 * 32; i += 512) { const int c = i >> 5, d4 = (i & 31) * 4; *(LAS f32x4*)(AD + c * 128 + d4) = *(const f32x4*)(ADEC + ((size_t)c * 16 + h) * 128 + d4); }
        __syncthreads();
        f32x2 S = (f32x2){0.f, 0.f};
        for (int c0 = 0; c0 < 240; c0 += 16) {
#pragma unroll
            for (int q = 0; q < 16; ++q) { const int c = c0 + q; const unsigned w_ = ring[q];
                ring[q] = *(const unsigned*)(up + (size_t)(c + 16) * cst);
                const f32x2 a = *(const LAS f32x2*)(AD + c * 128 + d);
                *(unsigned*)(sp + (size_t)c * cst) = pk2(S[0], S[1]);
                S = a * S + (f32x2){__uint_as_float(w_ << 16), __uint_as_float(w_ & 0xffff0000u)}; } }
#pragma unroll
        for (int q = 0; q < 16; ++q) { const int c = 240 + q; const unsigned w_ = ring[q];
            const f32x2 a = *(const LAS f32x2*)(AD + c * 128 + d);
            *(unsigned*)(sp + (size_t)c * cst) = pk2(S[0], S[1]);
            S = a * S + (f32x2){__uint_as_float(w_ << 16), __uint_as_float(w_ & 0xffff0000u)}; }
        float* o = F.out + O_HGP + ((size_t)h * 128 + d) * 128 + v; o[0] = S[0]; o[128] = S[1];
        __syncthreads(); }
    const float* S0 = F.in[I_SHG];
    for (int e = gt; e < 8 * 16 * 128 * 64; e += NT) { const int dp = e & 63, v = (e >> 6) & 127, sh = e >> 13, d = 2 * dp;
        const size_t u = 4096 + sh; const size_t so = ((size_t)sh * 128 + d) * 128 + v;
        const f32x2 S = (f32x2){S0[so], S0[so + 128]};
        const f32x2 a = *(const f32x2*)(ADEC + u * 128 + d), ut = UT2(UT + (u * 128 + v) * 128 + d);
        *(unsigned*)(ST + (u * 128 + v) * 128 + d) = pk2(S[0], S[1]);
        const f32x2 Sn = a * S + ut;
        float* o = F.out + O_HGS + so; o[0] = Sn[0]; o[128] = Sn[1]; }
}
__device__ __forceinline__ void hg_pass3(Frame& F) {
    LAS unsigned char* L = F.lds;
    LAS bf16* STl = (LAS bf16*)L; LAS bf16* Q0l = (LAS bf16*)(L + 34816); LAS float* SS = (LAS float*)(L + 52224);
    const bf16* ST = (const bf16*)(F.ws + WS_ST); const bf16* Q0 = (const bf16*)(F.ws + WS_Q0); const bf16* OI = (const bf16*)(F.ws + WS_OI);
    const bf16* ZH = (const bf16*)(F.ws + WS_ZH); bf16* OA = (bf16*)(F.ws + WS_OA); const float* ng = F.in[I_HGNG];
    const int tid = F.tid, w = F.wave, lane = F.lane, r = lane & 31, hh = lane >> 5;
    for (int u = blockIdx.x; u < HGU; u += F.G) {
        int h, row0, nvalid; hg_decode(u, h, row0, nvalid);
#pragma unroll
        for (int i = 0; i < 4; ++i) { const int c = tid + 512 * i, v = c >> 4, d8 = (c & 15) * 8;
            *(LAS u32x4*)(STl + v * 136 + d8) = *(const u32x4*)(ST + ((size_t)u * 128 + v) * 128 + d8); }
#pragma unroll
        for (int i = 0; i < 2; ++i) { const int c = tid + 512 * i, t = c >> 4, d8 = (c & 15) * 8;
            u32x4 x = (u32x4){0u, 0u, 0u, 0u}; if (t < nvalid) x = *(const u32x4*)(Q0 + (size_t)(row0 + t) * DH + h * 128 + d8);
            *(LAS u32x4*)(Q0l + t * 136 + d8) = x; }
        const int tv = w >> 1, tt = w & 1, t = 32 * tt + r; const bool tvalid = t < nvalid;
        const size_t rowg = (size_t)(row0 + (tvalid ? t : 0));
        const int vb = h * 128 + 32 * tv + 4 * hh;
        f32x4 oi[4]; u32x2 gwv[4];
#pragma unroll
        for (int g = 0; g < 4; ++g) { const u32x2 ow = *(const u32x2*)(OI + rowg * DH + vb + 8 * g); oi[g] = (f32x4){__uint_as_float(ow.x << 16), __uint_as_float(ow.x & 0xffff0000u), __uint_as_float(ow.y << 16), __uint_as_float(ow.y & 0xffff0000u)};
            gwv[g] = *(const u32x2*)(ZH + rowg * LDZH + 6144 + vb + 8 * g); }
        __syncthreads();
        f32x16 acc; for (int i = 0; i < 16; ++i) acc[i] = 0.f;
#pragma unroll
        for (int ks = 0; ks < 8; ++ks) { const bf16x8 a = *(const LAS bf16x8*)(STl + (32 * tv + r) * 136 + 16 * ks + 8 * hh), b = *(const LAS bf16x8*)(Q0l + (32 * tt + r) * 136 + 16 * ks + 8 * hh);
            acc = MFMA32(a, b, acc); }
        float ss = 0.f;
#pragma unroll
        for (int g = 0; g < 4; ++g) {
#pragma unroll
            for (int j = 0; j < 4; ++j) { acc[4 * g + j] += oi[g][j]; ss += acc[4 * g + j] * acc[4 * g + j]; } }
        ss += __shfl_xor(ss, 32);
        if (hh == 0) SS[t * 4 + tv] = ss;
        __syncthreads();
        const float tot = (SS[t * 4] + SS[t * 4 + 1]) + (SS[t * 4 + 2] + SS[t * 4 + 3]);
        const float rs = 1.f / sqrtf(tot * (1.f / 128.f) + 1e-6f);
        if (tvalid) {
#pragma unroll
            for (int g = 0; g < 4; ++g) { const int col = vb + 8 * g;
                const f32x4 gn = *(const f32x4*)(ng + col); const u32x2 gw = gwv[g];
                const float g0 = __uint_as_float(gw.x << 16), g1 = __uint_as_float(gw.x & 0xffff0000u), g2 = __uint_as_float(gw.y << 16), g3 = __uint_as_float(gw.y & 0xffff0000u);
                const float o0 = acc[4 * g] * rs * gn[0] * (g0 * sigmoidf_(g0)), o1 = acc[4 * g + 1] * rs * gn[1] * (g1 * sigmoidf_(g1));
                const float o2 = acc[4 * g + 2] * rs * gn[2] * (g2 * sigmoidf_(g2)), o3 = acc[4 * g + 3] * rs * gn[3] * (g3 * sigmoidf_(g3));
                *(u32x2*)(OA + rowg * DH + col) = (u32x2){pk2(o0, o1), pk2(o2, o3)}; } }
        __syncthreads();
    }
}

__device__ __forceinline__ float dpp_xor1(float x) { return __builtin_bit_cast(float, __builtin_amdgcn_update_dpp(0, __builtin_bit_cast(int, x), 0xB1, 0xF, 0xF, true)); }
__device__ __forceinline__ float dpp_xor2(float x) { return __builtin_bit_cast(float, __builtin_amdgcn_update_dpp(0, __builtin_bit_cast(int, x), 0x4E, 0xF, 0xF, true)); }
__device__ __forceinline__ float dpp_hmir(float x) { return __builtin_bit_cast(float, __builtin_amdgcn_update_dpp(0, __builtin_bit_cast(int, x), 0x141, 0xF, 0xF, true)); }
__device__ __forceinline__ float dpp_mir(float x)  { return __builtin_bit_cast(float, __builtin_amdgcn_update_dpp(0, __builtin_bit_cast(int, x), 0x140, 0xF, 0xF, true)); }
__device__ __forceinline__ float red16(float x) { x += dpp_xor1(x); x += dpp_xor2(x); x += dpp_hmir(x); x += dpp_mir(x); return x; }
__device__ __forceinline__ float wsum(float x) {
    x = red16(x); const int xi = __builtin_bit_cast(int, x);
    const float r0 = __builtin_bit_cast(float, __builtin_amdgcn_readlane(xi, 0)), r1 = __builtin_bit_cast(float, __builtin_amdgcn_readlane(xi, 16));
    const float r2 = __builtin_bit_cast(float, __builtin_amdgcn_readlane(xi, 32)), r3 = __builtin_bit_cast(float, __builtin_amdgcn_readlane(xi, 48));
    return (r0 + r1) + (r2 + r3);
}
__device__ __forceinline__ float zr_prev(const bf16* ZR, const float* sh0, int row, int col) {
    if (row < MPR) return row == 0 ? 0.f : bf2f(ZR[(size_t)(row - 1) * LDZR + col]);
    const int q = row - MPR, s = q >> 4, t = q & 15;
    return t == 0 ? sh0[(size_t)s * DRIN + col] : bf2f(ZR[(size_t)(row - 1) * LDZR + col]);
}
__device__ __forceinline__ void rw_lora_in(Frame& F) {
    const bf16* ZR = (const bf16*)(F.ws + WS_ZR); bf16* AL = (bf16*)(F.ws + WS_AL); const float* mu = F.in[I_MU]; const float* sh0 = F.in[I_SSH];
    for (int row = F.gw; row < MP; row += F.NGW) {
        float o[16];
#pragma unroll
        for (int it = 0; it < 16; ++it) { const int c = F.lane + 64 * it;
            int src = -1, mode = 0;
            if (it < 2) { src = 6144 + c; mode = 0; } else if (it >= 4 && it < 6) { src = 6272 + (c - 256); mode = 1; } else if (it >= 8) { src = 6400 + (c - 512); mode = 2; if (c >= 992) src = -1; }
            o[it] = 0.f;
            if (src >= 0 && row < MR) { const float cur = bf2f(ZR[(size_t)row * LDZR + src]), prev = zr_prev(ZR, sh0, row, src); const float zs = cur + (prev - cur) * mu[src];
                o[it] = mode == 0 ? tanhf(zs) : (mode == 1 ? zs : sigmoidf_(zs)); } }
#pragma unroll
        for (int it = 0; it < 16; ++it) AL[(size_t)row * 1024 + F.lane + 64 * it] = (bf16)f2bf(o[it]);
    }
    for (int q = F.gw; q < 9; q += F.NGW) { const int row = q == 0 ? MPR - 1 : MPR + 16 * (q - 1) + 15; float* o = q == 0 ? F.out + O_SHP : F.out + O_SHS + (size_t)(q - 1) * DRIN;
        for (int c = F.lane; c < DRIN; c += 64) o[c] = bf2f(ZR[(size_t)row * LDZR + c]); }
}
__device__ __forceinline__ void rw_unit_decode(int u, int& h, int& row0, int& n, int& rec0) {
    if (u < 8192) { h = u >> 8; const int c = u & 255; row0 = 64 * c; n = 64; rec0 = h * MPR + row0; }
    else { const int q = u - 8192, s = q >> 5; h = q & 31; row0 = MPR + 16 * s; n = 16; rec0 = 32 * MPR + q * 16; }
}
__device__ __forceinline__ void rw_prep(Frame& F) {
    const bf16* ZR = (const bf16*)(F.ws + WS_ZR); const bf16* LOGW = (const bf16*)F.out; const bf16* ASIG = (const bf16*)F.out + (size_t)MP * DH;
    float* REC = (float*)(F.ws + WS_REC); float* RK = (float*)(F.ws + WS_RK); float* WC = (float*)(F.ws + WS_WC); float* VS = (float*)(F.ws + WS_VS);
    const float* mu = F.in[I_MU]; const float* sh0 = F.in[I_SSH];
    const int lane = F.lane;
    for (int u = F.gw; u < RWU; u += F.NGW) {
        int h, row0, n, rec0; rw_unit_decode(u, h, row0, n, rec0);
        const int col = h * 64 + lane;
        const float mur = mu[col], muk = mu[2048 + col], muv = mu[4096 + col], kkw = F.in[I_KK][col], kaw = F.in[I_KA][col], rkw = F.in[I_RK][col];
        float pr = zr_prev(ZR, sh0, row0, col), pk = zr_prev(ZR, sh0, row0, 2048 + col), pv = zr_prev(ZR, sh0, row0, 4096 + col);
        float Lw = 0.f;
        bf16 cr[8], ck[8], cv[8], lw[8], as[8], nr[8], nk[8], nv[8], nl[8], na[8];
        const bf16* zp = ZR + (size_t)row0 * LDZR + col; const bf16* lp = LOGW + (size_t)row0 * DH + col; const bf16* ap = ASIG + (size_t)row0 * DH + col;
#define PREP_LD(R_, K_, V_, L_, A_, t) do { _Pragma("unroll") for (int q = 0; q < 8; ++q) { const size_t o_ = (size_t)((t) + q); R_[q] = zp[o_ * LDZR]; K_[q] = zp[o_ * LDZR + 2048]; V_[q] = zp[o_ * LDZR + 4096]; L_[q] = lp[o_ * DH]; A_[q] = ap[o_ * DH]; } } while (0)
        PREP_LD(cr, ck, cv, lw, as, 0);
        for (int t0 = 0; t0 < n; t0 += 8) {
            { const int tn = t0 + 8 < n ? t0 + 8 : t0; PREP_LD(nr, nk, nv, nl, na, tn); }
#pragma unroll
            for (int q = 0; q < 8; ++q) { const int row = row0 + t0 + q;
                const float crq = bf2f(cr[q]), ckq = bf2f(ck[q]), cvq = bf2f(cv[q]);
                const float rr = crq + (pr - crq) * mur, kv = ckq + (pk - ckq) * muk;
                const float nx = -bf2f(lw[q]); const float sp = fmaxf(nx, 0.f) + __logf(1.0f + __expf(-fabsf(nx))); const float lgw = -__expf(-sp - 0.5f); const float asg = sigmoidf_(bf2f(as[q]));
                float kk = kv * kkw; const float nrm = sqrtf(wsum(kk * kk)); kk = kk / fmaxf(nrm, 1e-12f);
                const float k_ = kv * (1.f + (asg - 1.f) * kaw);
                const float rk = wsum(rr * k_ * rkw);
                const float eex = __expf(Lw); Lw += lgw; const float ein = __expf(Lw), einv = __expf(-Lw);
                float* rec = REC + (size_t)(rec0 + t0 + q) * 256;
                rec[lane] = -kk * eex; rec[64 + lane] = kk * asg * einv; rec[128 + lane] = k_ * einv; rec[192 + lane] = rr * ein;
                if (lane == 0) RK[(size_t)row * 32 + h] = rk;
                VS[(size_t)row * DH + col] = cvq + (pv - cvq) * muv;
                pr = crq; pk = ckq; pv = cvq; }
#pragma unroll
            for (int q = 0; q < 8; ++q) { cr[q] = nr[q]; ck[q] = nk[q]; cv[q] = nv[q]; lw[q] = nl[q]; as[q] = na[q]; }
        }
#undef PREP_LD
        WC[(size_t)u * 64 + lane] = __expf(Lw);
    }
}
#define SCAN_BAR() do { asm volatile("s_waitcnt lgkmcnt(0)" ::: "memory"); __builtin_amdgcn_s_barrier(); asm volatile("" ::: "memory"); } while (0)
#define SCAN_BAR() do { asm volatile("s_waitcnt lgkmcnt(0)" ::: "memory"); __builtin_amdgcn_s_barrier(); asm volatile("" ::: "memory"); } while (0)
constexpr int TB = 4, NBUF = 4;
struct ScanState { f32x4 A[4], B[4]; };
__device__ __forceinline__ float ksum(float p) { const f32x4 z = (f32x4){0.f, 0.f, 0.f, 0.f}; const f32x4 d = __builtin_amdgcn_mfma_f32_16x16x4f32(1.0f, p, z, 0, 0, 0); return d[0]; }
__device__ __forceinline__ float dot16(const f32x4 (&S)[4], const f32x4 (&a)[4]) {
    f32x2 p0 = (f32x2){S[0][0], S[0][1]} * (f32x2){a[0][0], a[0][1]}, p1 = (f32x2){S[0][2], S[0][3]} * (f32x2){a[0][2], a[0][3]};
#pragma unroll
    for (int q = 1; q < 4; ++q) { p0 = __builtin_elementwise_fma((f32x2){S[q][0], S[q][1]}, (f32x2){a[q][0], a[q][1]}, p0); p1 = __builtin_elementwise_fma((f32x2){S[q][2], S[q][3]}, (f32x2){a[q][2], a[q][3]}, p1); }
    const f32x2 t = p0 + p1; return t[0] + t[1];
}
template <bool useB>
__device__ __forceinline__ void rw_block4(ScanState& st, const LAS unsigned char* pb, const LAS float* pv, float* outA, float* outB, int kg) {
    f32x4 oa[4], ob[4], ok[4], orr[2][4]; float ov;
#define RW_LD4(dst, P) do { _Pragma("unroll") for (int e = 0; e < 4; ++e) dst[e] = *(const LAS f32x4*)((P) + e * 16); } while (0)
    RW_LD4(oa, pb); RW_LD4(ob, pb + 256); RW_LD4(ok, pb + 512); RW_LD4(orr[0], pb + 768); ov = *pv;
    float ykA = 0.f, ykB = 0.f;
    const f32x4 z = (f32x4){0.f, 0.f, 0.f, 0.f};
#pragma unroll
    for (int ss = 0; ss < 4; ++ss) {
        const bool more = ss < 3;
        const LAS unsigned char* pn = pb + (ss + 1) * 1024; const LAS float* vn = pv + (ss + 1) * 16;
        const float pa = dot16(st.A, oa), pq = useB ? dot16(st.B, oa) : 0.f;
        const f32x4 da = __builtin_amdgcn_mfma_f32_16x16x4f32(1.0f, pa, z, 0, 0, 0);
        f32x4 db = z; if (useB) db = __builtin_amdgcn_mfma_f32_16x16x4f32(1.0f, pq, z, 0, 0, 0);
        if (more) RW_LD4(oa, pn);
        if (ss > 0) { const float y = ksum(dot16(st.A, orr[(ss + 1) & 1])); ykA = (kg == ss - 1) ? y : ykA;
            if (useB) { const float c = ksum(dot16(st.B, orr[(ss + 1) & 1])); ykB = (kg == ss - 1) ? c : ykB; } }
        if (more) RW_LD4(orr[(ss + 1) & 1], pn + 768);
        const float sa = da[0], sb = db[0];
        const f32x4 sa4 = (f32x4){sa, sa, sa, sa}, sb4 = (f32x4){sb, sb, sb, sb}, v4 = (f32x4){ov, ov, ov, ov};
#pragma unroll
        for (int e = 0; e < 4; ++e) { st.A[e] = __builtin_elementwise_fma(ob[e], sa4, st.A[e]); st.A[e] = __builtin_elementwise_fma(ok[e], v4, st.A[e]); if (useB) st.B[e] = __builtin_elementwise_fma(ob[e], sb4, st.B[e]); }
        if (more) { RW_LD4(ob, pn + 256); RW_LD4(ok, pn + 512); ov = *vn; }
    }
    { const float y = ksum(dot16(st.A, orr[1])); ykA = (kg == 3) ? y : ykA; outA[(size_t)kg * DH] = ykA;
      if (useB) { const float c = ksum(dot16(st.B, orr[1])); ykB = (kg == 3) ? c : ykB; outB[(size_t)kg * DH] = ykB; } }
#undef RW_LD4
}
__device__ __forceinline__ void rw_issue(Frame& F, int w, int k, int rec, const float* vrow0, const float* wcp, int par, int lane) {
    const float* REC = (const float*)(F.ws + WS_REC);
    LAS unsigned char* dst = F.lds + w * 16384 + k * 4096;
    const unsigned* gp = (const unsigned*)(REC + (size_t)rec * 256 + lane * 4); LAS unsigned* lp = (LAS unsigned*)dst;
    __builtin_amdgcn_global_load_lds(gp, lp, 16, 0, 0); __builtin_amdgcn_global_load_lds(gp, lp, 16, 1024, 0); __builtin_amdgcn_global_load_lds(gp, lp, 16, 2048, 0); __builtin_amdgcn_global_load_lds(gp, lp, 16, 3072, 0);
    __builtin_amdgcn_global_load_lds((const unsigned*)(vrow0 + (size_t)(lane >> 4) * DH + (lane & 15)), (LAS unsigned*)(F.lds + 131072 + w * 1024 + k * 256), 4, 0, 0);
    __builtin_amdgcn_global_load_lds((const unsigned*)(wcp + lane), (LAS unsigned*)(F.lds + 139264 + w * 512 + par * 256), 4, 0, 0);
}
template <bool useB>
__device__ __forceinline__ void rw_job(Frame& F, ScanState& st, int rec0, const float* vrow0, const float* wcp0, int nsteps, float* outA0, float* outB0, int w, int lane) {
    const int r = lane & 15, kg = lane >> 4; const int nb = nsteps / TB;
#define RW_ISS(bb) rw_issue(F, w, (bb) & 3, rec0 + (bb) * TB, vrow0 + (size_t)((bb) * TB) * DH, wcp0 + ((bb) >> 4) * 64, ((bb) >> 4) & 1, lane)
    RW_ISS(0); if (nb > 1) RW_ISS(1); if (nb > 2) RW_ISS(2);
    for (int b = 0; b < nb; ++b) {
        if (b + 3 < nb) { RW_ISS(b + 3); asm volatile("s_waitcnt vmcnt(18)" ::: "memory"); }
        else asm volatile("s_waitcnt vmcnt(0)" ::: "memory");
        const LAS unsigned char* pb = F.lds + w * 16384 + (b & 3) * 4096 + kg * 64; const LAS float* pv = (const LAS float*)(F.lds + 131072 + w * 1024 + (b & 3) * 256) + r;
        rw_block4<useB>(st, pb, pv, outA0 + (size_t)(b * TB) * DH, useB ? outB0 + (size_t)(b * TB) * DH : nullptr, kg);
        if ((b & 15) == 15 || b == nb - 1) {
#pragma unroll
            for (int e = 0; e < 4; ++e) { const f32x4 wc = *(const LAS f32x4*)(F.lds + 139264 + w * 512 + ((b >> 4) & 1) * 256 + kg * 64 + e * 16); st.A[e] = st.A[e] * wc; if (useB) st.B[e] = st.B[e] * wc; } }
        asm volatile("s_waitcnt lgkmcnt(0)" ::: "memory");
    }
#undef RW_ISS
}
__device__ __forceinline__ void rw_scan_prompt(Frame& F, int h, int sl, int half) {
    const float* WC = (const float*)(F.ws + WS_WC); const float* VS = (const float*)(F.ws + WS_VS);
    float* Y = (float*)(F.ws + WS_Y); float* C = (float*)(F.ws + WS_C); float* SZ = (float*)(F.ws + WS_SZ); float* SQ = (float*)(F.ws + WS_SQ);
    const int w = F.wave, lane = F.lane, r = lane & 15, kg = lane >> 4;
    const int seg = 8 * half + w; const bool useB = seg > 0;
    const int row = 16 * sl + r;
    ScanState st;
#pragma unroll
    for (int e = 0; e < 4; ++e) { st.A[e] = (f32x4){0.f, 0.f, 0.f, 0.f};
#pragma unroll
        for (int c = 0; c < 4; ++c) st.B[e][c] = (16 * kg + 4 * e + c == row) ? 1.f : 0.f; }
    const int t0 = seg * SEGLEN;
    if (useB) rw_job<true>(F, st, h * MPR + t0, VS + (size_t)t0 * DH + h * 64 + 16 * sl, WC + (size_t)(h * 256 + (t0 >> 6)) * 64, SEGLEN, Y + (size_t)t0 * DH + h * 64 + row, C + (size_t)(t0 - SEGLEN) * DH + h * 64 + row, w, lane);
    else rw_job<false>(F, st, h * MPR + t0, VS + (size_t)t0 * DH + h * 64 + 16 * sl, WC + (size_t)(h * 256 + (t0 >> 6)) * 64, SEGLEN, Y + (size_t)t0 * DH + h * 64 + row, nullptr, w, lane);
    { float* so = SZ + ((size_t)(h * NSEG + seg) * 64 + row) * 64 + 16 * kg;
#pragma unroll
      for (int e = 0; e < 4; ++e) *(f32x4*)(so + 4 * e) = st.A[e]; }
    if (useB) { float* so = SQ + ((size_t)(h * NSEG + seg) * 64 + row) * 64 + 16 * kg;
#pragma unroll
        for (int e = 0; e < 4; ++e) *(f32x4*)(so + 4 * e) = st.B[e]; }
}
__device__ __forceinline__ void rw_scan_sample(Frame& F) {
    const float* WC = (const float*)(F.ws + WS_WC); const float* VS = (const float*)(F.ws + WS_VS); float* Y = (float*)(F.ws + WS_Y);
    const int w = F.wave, lane = F.lane, r = lane & 15, kg = lane >> 4;
    for (int q = F.gw; q < 1024; q += F.NGW) { const int sl = q & 3, sh = q >> 2, hh = sh & 31, sq = sh >> 5; const int row = 16 * sl + r;
        const float* S0 = F.in[I_SRW] + (size_t)sh * 4096 + (size_t)row * 64 + 16 * kg;
        ScanState st;
#pragma unroll
        for (int e = 0; e < 4; ++e) { st.A[e] = *(const f32x4*)(S0 + 4 * e); st.B[e] = (f32x4){0.f, 0.f, 0.f, 0.f}; }
        rw_job<false>(F, st, 32 * MPR + sh * 16, VS + (size_t)(MPR + 16 * sq) * DH + hh * 64 + 16 * sl, WC + (size_t)(8192 + sh) * 64, 16, Y + (size_t)(MPR + 16 * sq) * DH + hh * 64 + row, nullptr, w, lane);
        float* so = F.out + O_RWS + (size_t)sh * 4096 + (size_t)row * 64 + 16 * kg;
#pragma unroll
        for (int e = 0; e < 4; ++e) *(f32x4*)(so + 4 * e) = st.A[e];
    }
}
__device__ __forceinline__ void rw_scan(Frame& F) {
    for (int bb = blockIdx.x; bb < 256; bb += F.G) { const int x = bb & 7, i = bb >> 3, h = x * 4 + (i >> 3), j = i & 7; rw_scan_prompt(F, h, j >> 1, j & 1); }
    rw_scan_sample(F);
}
__device__ __forceinline__ void rw_compose(Frame& F) {
    const float* SZ = (const float*)(F.ws + WS_SZ); const float* SQ = (const float*)(F.ws + WS_SQ); float* SST = (float*)(F.ws + WS_SST);
    const int lane = F.lane, tid = F.tid;
    LAS float* Qb = (LAS float*)F.lds;
    for (int bb = blockIdx.x; bb < 256; bb += F.G) { const int x = bb & 7, i8 = bb >> 3, h = x * 4 + (i8 >> 3), v = 8 * (i8 & 7) + F.wave;
        const size_t hb = (size_t)(h * NSEG) * 4096;
        f32x4 q0 = *(const f32x4*)(SQ + hb + 4096 + tid * 8), q1 = *(const f32x4*)(SQ + hb + 4096 + tid * 8 + 4);
        float srow = SZ[hb + (size_t)v * 64 + lane];
        float nz = SZ[hb + 4096 + (size_t)v * 64 + lane];
        *(LAS f32x4*)(Qb + tid * 8) = q0; *(LAS f32x4*)(Qb + tid * 8 + 4) = q1;
        __syncthreads();
        for (int k = 1; k < NSEG; ++k) {
            float nzn = 0.f;
            if (k + 1 < NSEG) { const size_t o = hb + (size_t)(k + 1) * 4096; q0 = *(const f32x4*)(SQ + o + tid * 8); q1 = *(const f32x4*)(SQ + o + tid * 8 + 4); nzn = SZ[o + (size_t)v * 64 + lane]; }
            SST[hb + (size_t)k * 4096 + (size_t)v * 64 + lane] = srow;
            const LAS float* q = Qb + ((k - 1) & 1) * 4096 + lane;
            float n0 = nz, n1 = 0.f;
            const int si = __builtin_bit_cast(int, srow);
#pragma unroll
            for (int i = 0; i < 64; i += 2) { n0 = fmaf(__builtin_bit_cast(float, __builtin_amdgcn_readlane(si, i)), q[i * 64], n0); n1 = fmaf(__builtin_bit_cast(float, __builtin_amdgcn_readlane(si, i + 1)), q[(i + 1) * 64], n1); }
            srow = n0 + n1; nz = nzn;
            if (k + 1 < NSEG) { LAS float* qd = Qb + (k & 1) * 4096 + tid * 8; *(LAS f32x4*)qd = q0; *(LAS f32x4*)(qd + 4) = q1; }
            __syncthreads();
        }
        F.out[O_RWP + ((size_t)h * 64 + v) * 64 + lane] = srow;
    }
}
__device__ __forceinline__ void rw_post(Frame& F) {
    const float* Y = (const float*)(F.ws + WS_Y); const float* C = (const float*)(F.ws + WS_C); const float* SST = (const float*)(F.ws + WS_SST); const float* VS = (const float*)(F.ws + WS_VS);
    const float* RK = (const float*)(F.ws + WS_RK); const bf16* G = (const bf16*)(F.ws + WS_G);
    bf16* OB = (bf16*)(F.ws + WS_OB); const float* lng = F.in[I_LNG]; const float* lnb = F.in[I_LNB];
    const int lane = F.lane;
    for (int u = F.gw; u < 32 * (MR / 64); u += F.NGW) { const int h = u & 31, rb0 = (u >> 5) * 64, col = h * 64 + lane;
        const float g_ = lng[col], b_ = lnb[col];
        const int k = rb0 < MPR ? (rb0 / SEGLEN) : 0;
        f32x4 Sr[16];
        if (k > 0) {
#pragma unroll
            for (int q = 0; q < 16; ++q) Sr[q] = *(const f32x4*)(SST + ((size_t)(h * NSEG + k) * 64 + lane) * 64 + 4 * q); }
        const float* yp = Y + (size_t)rb0 * DH + col; const float* vp = VS + (size_t)rb0 * DH + col; const bf16* gp = G + (size_t)rb0 * DH + col; const float* rp = RK + (size_t)rb0 * 32 + h;
        const float* cp = k > 0 ? C + (size_t)(rb0 - SEGLEN) * DH + col : yp;
        float y[8], vv[8], rk[8], cc[8]; bf16 gg[8];
#define POST_LD(Y_, V_, G_, R_, C_, t) do { _Pragma("unroll") for (int q = 0; q < 8; ++q) { const size_t o_ = (size_t)((t) + q) * DH; Y_[q] = yp[o_]; V_[q] = vp[o_]; G_[q] = gp[o_]; R_[q] = rp[((t) + q) * 32]; C_[q] = cp[o_]; } } while (0)
        POST_LD(y, vv, gg, rk, cc, 0);
        for (int t0 = 0; t0 < 64; t0 += 8) {
            float ny[8], nv[8], nr[8], nc[8]; bf16 ng[8];
            const int tn = t0 + 8 < 64 ? t0 + 8 : t0;
            POST_LD(ny, nv, ng, nr, nc, tn);
            if (k > 0) {
                LAS float* cs = (LAS float*)(F.lds + 131072 + F.wave * 1024);
#pragma unroll
                for (int hf = 0; hf < 2; ++hf) {
#pragma unroll
                    for (int q = 0; q < 4; ++q) cs[q * 64 + lane] = cc[4 * hf + q];
                    asm volatile("s_waitcnt lgkmcnt(0)" ::: "memory");
#pragma unroll
                    for (int q = 0; q < 4; ++q) { f32x4 a = (f32x4){0.f, 0.f, 0.f, 0.f};
#pragma unroll
                        for (int i = 0; i < 16; ++i) a = __builtin_elementwise_fma(Sr[i], *(const LAS f32x4*)(cs + q * 64 + 4 * i), a);
                        y[4 * hf + q] += (a[0] + a[1]) + (a[2] + a[3]); }
                    asm volatile("s_waitcnt lgkmcnt(0)" ::: "memory"); }
            }
#pragma unroll
            for (int q = 0; q < 8; ++q) { const int row = rb0 + t0 + q;
                const float mean = wsum(y[q]) * (1.f / 64.f); const float dv = y[q] - mean; const float var = wsum(dv * dv) * (1.f / 64.f);
                const float yn = dv * (1.f / sqrtf(var + 64e-5f)) * g_ + b_;
                OB[(size_t)row * DH + col] = (bf16)f2bf((yn + rk[q] * vv[q]) * bf2f(gg[q])); }
#pragma unroll
            for (int q = 0; q < 8; ++q) { y[q] = ny[q]; vv[q] = nv[q]; gg[q] = ng[q]; rk[q] = nr[q]; cc[q] = nc[q]; }
        }
#undef POST_LD
    }
}

__global__ void __launch_bounds__(512, 2) fwd_kernel(Params P) {
    extern __shared__ __attribute__((aligned(16))) unsigned char lds_raw[];
    Frame F;
    F.lds = (LAS unsigned char*)lds_raw;
    F.tid = threadIdx.x; F.lane = F.tid & 63; F.wave = __builtin_amdgcn_readfirstlane(F.tid >> 6);
    F.G = gridDim.x; F.gw = blockIdx.x * 8 + F.wave; F.NGW = F.G * 8;
    F.in = P.in; F.out = P.out; F.ws = P.ws;
    volatile LAS unsigned* MISC = (volatile LAS unsigned*)(F.lds + MISC_OFF);
    if (F.tid < 32) MISC[F.tid] = 0u;
    __syncthreads();
    XcdBarrier bar = xcd_barrier_post((unsigned*)(P.ws + WS_CTL) + 1024, MISC + 8);
#define GRID_BAR() xcd_barrier(bar)
#ifndef PHASE_MASK
#define PHASE_MASK 0xFFFFFFFFu
#endif
#define PH(k) ((PHASE_MASK >> (k)) & 1u)
    bf16* XB = (bf16*)(P.ws + WS_XB); bf16* HB = (bf16*)(P.ws + WS_H);

    if (PH(0)) p0_prologue(F);
    GRID_BAR();
    if (PH(1)) { pg8::Gemm g{(const bf16*)(P.ws + WS_XB8), (const bf16*)(P.ws + WS_WFI), MP, NFF, D / 2, D / 2, D / 2}; pg8::StaticOrder S; S.init(MP, NFF, F.G, (int)blockIdx.x);
      pg8::EpiSwiGLU<2, true> E{HB}; pg8::gemm_phase(F.lds, g, S, E); }
    GRID_BAR();
    if (PH(2)) { pg8::Gemm g{HB, (const bf16*)(P.ws + WS_WFD), MPR, D, DFF / 2, DFF / 2, DFF / 2}; pg8::StaticOrder S; S.init(MPR, D, F.G, (int)blockIdx.x, 4);
      pg8::EpiResid<true, 1> E{(bf16*)(P.ws + WS_T1), P.in[I_XP], P.in[I_XS], nullptr, 0.5f / pg8::W8SCALE_DN}; pg8::gemm_phase(F.lds, g, S, E);
      SkResidSplit K2{(bf16*)(P.ws + WS_T1), P.in[I_XS], 0.5f / pg8::W8SCALE_DN}; skinny_phase<true>(F.lds, HB, DFF, (const bf16*)(P.ws + WS_WFD), DFF, DFF, K2); }
    GRID_BAR();
    if (PH(3)) ln_phase<true, false, true>(F, (const bf16*)(P.ws + WS_T1), P.in[I_LN1G], P.in[I_LN1B], P.ws + WS_H);
    GRID_BAR();
    if (PH(4)) { { pg8::Gemm g{XB, (const bf16*)(P.ws + WS_WIN), MP, 35 * 256, D, D, D}; pg8::StaticOrder S; S.init(MP, 35 * 256, F.G, (int)blockIdx.x);
        pg8::EpiZr<false> E{(bf16*)(P.ws + WS_ZH), (bf16*)(P.ws + WS_ZR), (bf16*)(P.ws + WS_ZG)}; pg8::gemm_phase(F.lds, g, S, E); }
      { pg8::Gemm g{(const bf16*)(P.ws + WS_H), (const bf16*)(P.ws + WS_WIN8), MP, 56 * 256, D / 2, D / 2, D / 2}; pg8::StaticOrder S; S.init(MP, 56 * 256, F.G, (int)((blockIdx.x + 29) % F.G));
        pg8::EpiZr<true> E{(bf16*)(P.ws + WS_ZH), (bf16*)(P.ws + WS_ZR), (bf16*)(P.ws + WS_ZG)}; pg8::gemm_phase(F.lds, g, S, E); } }
    GRID_BAR();
    if (PH(5)) { hg_pass1(F);
    rw_lora_in(F); }
    GRID_BAR();
    if (PH(6)) { hg_pass2(F);
      const bf16* AL = (const bf16*)(P.ws + WS_AL); bf16* LOGWo = (bf16*)P.out; bf16* ASIGo = (bf16*)P.out + (size_t)MP * DH;
      { pg8::Gemm g{AL, (const bf16*)(P.ws + WS_LW2), MP, DH, 256, 1024, 256}; pg8::StaticOrder S; S.init(MP, DH, F.G, (int)((blockIdx.x + F.G - 16) % F.G));
        pg8::EpiLoraF32 E{LOGWo, P.in[I_W0]}; pg8::gemm_phase(F.lds, g, S, E); }
      { pg8::Gemm g{AL + 256, (const bf16*)(P.ws + WS_LA2), MP, DH, 256, 1024, 256}; pg8::StaticOrder S; S.init(MP, DH, F.G, (int)((blockIdx.x + F.G - 8) % F.G));
        pg8::EpiLoraF32 E{ASIGo, P.in[I_A0]}; pg8::gemm_phase(F.lds, g, S, E); }
      { pg8::Gemm g{AL + 512, (const bf16*)(P.ws + WS_LG2), MP, DH, 512, 1024, 512}; pg8::StaticOrder S; S.init(MP, DH, F.G, (int)((blockIdx.x + F.G - 0) % F.G));
        pg8::EpiBf16Plain E{(bf16*)(P.ws + WS_G), DH}; pg8::gemm_phase(F.lds, g, S, E); } }
    GRID_BAR();
    if (PH(7)) hg_pass3(F);
    GRID_BAR();
    if (PH(9)) rw_prep(F);
    GRID_BAR();
    if (PH(10)) rw_scan(F);
    GRID_BAR();
    rw_compose(F);
    GRID_BAR();
    if (PH(11)) { rw_post(F);
    transpose_f8_matrix<1, true>(F, P.in[I_F2IN], D, NFF, P.ws + WS_WFI, I8_W);
    transpose_f8_matrix<0>(F, P.in[I_F2DN], DFF, D, P.ws + WS_WFD, pg8::W8SCALE_DN); }
    GRID_BAR();
    if (PH(12)) { pg8::Gemm g{(const bf16*)(P.ws + WS_OA), (const bf16*)(P.ws + WS_HGP), MPR, D, DH, DH, DH}; pg8::StaticOrder S; S.init(MPR, D, F.G, (int)blockIdx.x);
      pg8::EpiProj<true> E{(bf16*)(P.ws + WS_MB), (const bf16*)(P.ws + WS_ZG), 0, nullptr}; pg8::gemm_phase(F.lds, g, S, E);
      SkProj<true> K2{(bf16*)(P.ws + WS_MB), (const bf16*)(P.ws + WS_ZG), 0, nullptr}; skinny_phase(F.lds, (const bf16*)(P.ws + WS_OA), DH, (const bf16*)(P.ws + WS_HGP), DH, DH, K2); }
    asm volatile("s_waitcnt vmcnt(0)" ::: "memory"); __syncthreads();
    if (PH(13)) { pg8::Gemm g{(const bf16*)(P.ws + WS_OB), (const bf16*)(P.ws + WS_RWP), MPR, D, DH, DH, DH}; pg8::StaticOrder S; S.init(MPR, D, F.G, (int)blockIdx.x);
      pg8::EpiProj<false> E{(bf16*)(P.ws + WS_MB), (const bf16*)(P.ws + WS_ZG), 4096, P.ws + WS_XB8}; pg8::gemm_phase(F.lds, g, S, E);
      SkProj<false> K2{(bf16*)(P.ws + WS_MB), (const bf16*)(P.ws + WS_ZG), 4096, P.ws + WS_XB8}; skinny_phase(F.lds, (const bf16*)(P.ws + WS_OB), DH, (const bf16*)(P.ws + WS_RWP), DH, DH, K2); }
    GRID_BAR();
    if (PH(14)) { pg8::Gemm g{(const bf16*)(P.ws + WS_XB8), (const bf16*)(P.ws + WS_WOUT), MPR, D, D / 2, D / 2, D / 2}; pg8::StaticOrder S; S.init(MPR, D, F.G, (int)blockIdx.x, 4);
      pg8::EpiResid<false, 2> E{(bf16*)(P.ws + WS_T2), nullptr, nullptr, XB, I8_DEQ_OUT}; pg8::gemm_phase(F.lds, g, S, E);
      SkResidBf K2{(bf16*)(P.ws + WS_T2), XB, I8_DEQ_OUT}; skinny_phase<2>(F.lds, (const bf16*)(P.ws + WS_XB8), D, (const bf16*)(P.ws + WS_WOUT), D, D, K2); }
    GRID_BAR();
    if (PH(15)) ln_phase<true, false, true>(F, (const bf16*)(P.ws + WS_T2), P.in[I_LN2G], P.in[I_LN2B], P.ws + WS_XB8);
    GRID_BAR();
    if (PH(16)) { pg8::Gemm g{(const bf16*)(P.ws + WS_XB8), (const bf16*)(P.ws + WS_WFI), MP, NFF, D / 2, D / 2, D / 2}; pg8::StaticOrder S; S.init(MP, NFF, F.G, (int)blockIdx.x);
      pg8::EpiSwiGLU<2, true> E{HB}; pg8::gemm_phase(F.lds, g, S, E); }
    GRID_BAR();
    if (PH(17)) { unsigned char* wsp = P.ws; asm volatile("" : "+s"(wsp));
      bf16* xb17 = (bf16*)(wsp + WS_XB); bf16* hb17 = (bf16*)(wsp + WS_H);
      pg8::Gemm g{hb17, (const bf16*)(wsp + WS_WFD), MPR, D, DFF / 2, DFF / 2, DFF / 2}; pg8::StaticOrder S; S.init(MPR, D, F.G, (int)blockIdx.x, 4);
      pg8::EpiResid<false, 1> E{(bf16*)(wsp + WS_T3), nullptr, nullptr, xb17, 0.5f / pg8::W8SCALE_DN}; pg8::gemm_phase(F.lds, g, S, E);
      SkResidBf K2{(bf16*)(wsp + WS_T3), xb17, 0.5f / pg8::W8SCALE_DN}; skinny_phase<true>(F.lds, hb17, DFF, (const bf16*)(wsp + WS_WFD), DFF, DFF, K2); }
    GRID_BAR();
    if (PH(18)) ln_phase<false, true>(F, (const bf16*)(P.ws + WS_T3), P.in[I_LN3G], P.in[I_LN3B]);
}

extern "C" void kernel_launch(void* const* d_in, const int* in_sizes, int n_in, void* d_out, int out_size, void* d_ws, size_t ws_size, hipStream_t stream) {
    static int grid = 0;
    if (grid == 0) {
        if (n_in != 32 || out_size != (int)O_END || ws_size < WS_END) { fprintf(stderr, "kernel_launch: unexpected sizes n_in %d out %d ws %zu (need %zu)\n", n_in, out_size, ws_size, (size_t)WS_END); grid = -1; return; }
        int dev = 0, cus = 0;
        if (hipGetDevice(&dev) != hipSuccess || hipDeviceGetAttribute(&cus, hipDeviceAttributeMultiprocessorCount, dev) != hipSuccess) { grid = -1; return; }
        if (hipFuncSetAttribute((const void*)fwd_kernel, hipFuncAttributeMaxDynamicSharedMemorySize, LDS_BYTES) != hipSuccess) { fprintf(stderr, "kernel_launch: hipFuncSetAttribute failed\n"); grid = -1; return; }
        int per_cu = 0; (void)hipOccupancyMaxActiveBlocksPerMultiprocessor(&per_cu, (const void*)fwd_kernel, 512, LDS_BYTES); (void)hipGetLastError();
        if (per_cu < 1) fprintf(stderr, "kernel_launch: occupancy query reports %d\n", per_cu);
        grid = cus;
    }
    if (grid < 0) return;
    (void)hipMemsetAsync((char*)d_ws + WS_CTL, 0, CTL_ZERO_BYTES, stream);
    Params p{};
    for (int i = 0; i < 32; ++i) p.in[i] = (const float*)d_in[i];
    p.out = (float*)d_out; p.ws = (unsigned char*)d_ws;
    hipLaunchKernelGGL(fwd_kernel, dim3(grid), dim3(512), LDS_BYTES, stream, p);
}
```
